# Optimizing an MI355X kernel written in HIP

```python
import jax, jax.numpy as jnp
from jax import lax
import numpy as np


D_MODEL = 1024
BATCH = 16
SEQ = 2048
DEPTH = 2
DEC_BATCH = 8
DEC_SEQ = 64
PAST_LEN = 4096

CHUNK = 64
POOL_WIDTH = 512
POOL_GROUPS = 4
POOL_GROUP_WIDTH = POOL_WIDTH // POOL_GROUPS
POOL_WINDOWS = (2, 4, 8, 16)
POOL_STATE = max(POOL_WINDOWS) - 1
N_HEADS = 8
HEAD_DIM = 64
ATTN_WIDTH = N_HEADS * HEAD_DIM
IDX_HEADS = 8
IDX_DIM = 32
TOPK_MAX = 256
QUERY_BLOCK = 128
ROPE_THETA = 10000.0
EPS = 1e-6
IN_SIZES = (POOL_WIDTH, POOL_WIDTH, ATTN_WIDTH, ATTN_WIDTH, ATTN_WIDTH,
            IDX_HEADS * IDX_DIM, IDX_DIM, IDX_HEADS, ATTN_WIDTH, D_MODEL, D_MODEL)
IN_COLS = sum(IN_SIZES)

kernel_name = 'streaming_pool_dsa_hybrid_step'


def rms_norm(x, g):
    xf = x.astype(jnp.float32)
    r = lax.rsqrt(jnp.mean(xf * xf, axis=-1, keepdims=True) + EPS)
    return (xf * r * g.astype(jnp.float32)).astype(x.dtype)


def rope(x, pos):
    d = x.shape[-1]
    inv = ROPE_THETA ** (-jnp.arange(0, d, 2, dtype=jnp.float32) / d)
    ang = pos.astype(jnp.float32)[:, None] * inv[None, :]
    cos = jnp.cos(ang)[:, None, :]
    sin = jnp.sin(ang)[:, None, :]
    xf = x.astype(jnp.float32)
    x1, x2 = xf[..., : d // 2], xf[..., d // 2:]
    return jnp.concatenate([x1 * cos - x2 * sin, x2 * cos + x1 * sin], axis=-1).astype(x.dtype)


def pool_mix(u, left, pos, w_mix, scale):
    B, T, P = u.shape
    up = jnp.concatenate([left, u], axis=1).astype(jnp.float32)
    c = jnp.concatenate([jnp.zeros((B, 1, P), jnp.float32), jnp.cumsum(up, axis=1)], axis=1)
    end = c[:, POOL_STATE + 1:]
    means = []
    for gi, w in enumerate(POOL_WINDOWS):
        sl = slice(gi * POOL_GROUP_WIDTH, (gi + 1) * POOL_GROUP_WIDTH)
        start = c[:, POOL_STATE + 1 - w: POOL_STATE + 1 - w + T, sl]
        cnt = jnp.minimum(pos + 1, w).astype(jnp.float32)[None, :, None]
        means.append((end[..., sl] - start) / cnt)
    pooled = jnp.concatenate(means, axis=-1) - up[:, POOL_STATE:]
    mixed = jnp.einsum('btgc,gcd->btgd',
                       pooled.reshape(B, T, POOL_GROUPS, POOL_GROUP_WIDTH),
                       w_mix.astype(jnp.float32)).reshape(B, T, P)
    mixed = mixed * scale.astype(jnp.float32)
    new_state = up[:, -POOL_STATE:].astype(u.dtype)
    return mixed.astype(u.dtype), new_state


def dsa_attend(q, qi, wi, k, v, ki, q_pos, k_pos, k_sel):
    B, T, H, Dh = q.shape
    qb = min(QUERY_BLOCK, T)
    nb = T // qb

    def blk(r):
        return r.reshape((B * nb, qb) + r.shape[2:])

    xs = (blk(q), blk(qi), blk(wi),
          jnp.tile(q_pos.reshape(nb, qb), (B, 1)),
          jnp.repeat(jnp.arange(B, dtype=jnp.int32), nb))
    k_chunk = k_pos // CHUNK

    def one(args):
        qB, qiB, wB, pB, b = args
        kB, vB, kiB = k[b], v[b], ki[b]
        s = jnp.einsum('thd,sd->ths', qiB.astype(jnp.float32), kiB.astype(jnp.float32)) * IDX_DIM ** -0.5
        score = jnp.einsum('th,ths->ts', wB.astype(jnp.float32), jax.nn.relu(s)) * IDX_HEADS ** -0.5
        adm = k_chunk[None, :] <= (pB // CHUNK)[:, None]
        score = jnp.where(adm, score, -jnp.inf)
        _, sel = lax.top_k(score, k_sel)
        ok = jnp.take_along_axis(adm, sel, axis=1)
        kg = kB[sel].astype(jnp.float32)
        vg = vB[sel].astype(jnp.float32)
        logit = jnp.einsum('thd,tkhd->thk', qB.astype(jnp.float32), kg) * Dh ** -0.5
        logit = jnp.where(ok[:, None, :], logit, -jnp.inf)
        p = jax.nn.softmax(logit, axis=-1)
        return jnp.einsum('thk,tkhd->thd', p, vg).astype(q.dtype)

    out = lax.map(one, xs)
    return out.reshape(B, T, H * Dh)


def layer(x, pos, k_pos, past_k, past_v, past_ki, pool_left, k_sel,
          norm_g, w_in, w_pool_mix, pool_scale, w_pool_out, w_attn_out, w_o):
    B, T, _ = x.shape
    h = rms_norm(x, norm_g)
    proj = h @ w_in
    split_points = np.cumsum(IN_SIZES)[:-1].tolist()
    u_p, z_p, q, k, v, qi, ki, wi, z_a, g_p, g_a = jnp.split(proj, split_points, axis=-1)
    pooled, pool_state = pool_mix(u_p, pool_left, pos, w_pool_mix, pool_scale)
    br_pool = (pooled * jax.nn.silu(z_p)) @ w_pool_out
    q = rope(q.reshape(B, T, N_HEADS, HEAD_DIM), pos)
    k = rope(k.reshape(B, T, N_HEADS, HEAD_DIM), pos)
    v = v.reshape(B, T, N_HEADS, HEAD_DIM)
    qi = rope(qi.reshape(B, T, IDX_HEADS, IDX_DIM), pos)
    ki = rope(ki[:, :, None, :], pos)[:, :, 0]
    if past_k is None:
        k_all, v_all, ki_all = k, v, ki
    else:
        k_all = jnp.concatenate([past_k, k], axis=1)
        v_all = jnp.concatenate([past_v, v], axis=1)
        ki_all = jnp.concatenate([past_ki, ki], axis=1)
    o = dsa_attend(q, qi, wi, k_all, v_all, ki_all, pos, k_pos, k_sel)
    br_attn = (o * jax.nn.silu(z_a)) @ w_attn_out
    merged = jax.nn.sigmoid(g_p) * br_pool + jax.nn.sigmoid(g_a) * br_attn
    x = x + merged @ w_o
    return x, k, v, ki, pool_state


def setup_inputs(seed: int = 0) -> dict:
    key = jax.random.key(seed)
    ks = jax.random.split(key, 16)
    f32 = jnp.float32
    return {
        'x_prompt': jax.random.normal(ks[0], (BATCH, SEQ, D_MODEL), f32),
        'x_sample': jax.random.normal(ks[1], (DEC_BATCH, DEC_SEQ, D_MODEL), f32),
        'cache_k': jax.random.normal(ks[2], (DEPTH, DEC_BATCH, PAST_LEN, N_HEADS, HEAD_DIM), f32),
        'cache_v': jax.random.normal(ks[3], (DEPTH, DEC_BATCH, PAST_LEN, N_HEADS, HEAD_DIM), f32),
        'cache_kidx': jax.random.normal(ks[4], (DEPTH, DEC_BATCH, PAST_LEN, IDX_DIM), f32),
        'state_pool': jax.random.normal(ks[5], (DEPTH, DEC_BATCH, POOL_STATE, POOL_WIDTH), f32),
        'norm_g': 1.0 + 0.02 * jax.random.normal(ks[6], (DEPTH, D_MODEL), f32),
        'w_in': jax.random.normal(ks[7], (DEPTH, D_MODEL, IN_COLS), f32) * D_MODEL ** -0.5,
        'w_pool_mix': jax.random.normal(ks[8], (DEPTH, POOL_GROUPS, POOL_GROUP_WIDTH, POOL_GROUP_WIDTH), f32) * POOL_GROUP_WIDTH ** -0.5,
        'pool_scale': 1.0 + 0.02 * jax.random.normal(ks[9], (DEPTH, POOL_WIDTH), f32),
        'w_pool_out': jax.random.normal(ks[10], (DEPTH, POOL_WIDTH, D_MODEL), f32) * POOL_WIDTH ** -0.5,
        'w_attn_out': jax.random.normal(ks[11], (DEPTH, ATTN_WIDTH, D_MODEL), f32) * ATTN_WIDTH ** -0.5,
        'w_o': jax.random.normal(ks[12], (DEPTH, D_MODEL, D_MODEL), f32) * D_MODEL ** -0.5,
        'final_norm_g': 1.0 + 0.02 * jax.random.normal(ks[13], (D_MODEL,), f32),
    }


def reference(x_prompt, x_sample, cache_k, cache_v, cache_kidx, state_pool,
              norm_g, w_in, w_pool_mix, pool_scale, w_pool_out, w_attn_out, w_o, final_norm_g):
    Bp, Tp, _ = x_prompt.shape
    Bs, Ts, _ = x_sample.shape
    past = cache_k.shape[2]
    pos_p = jnp.arange(Tp, dtype=jnp.int32)
    pos_s = past + jnp.arange(Ts, dtype=jnp.int32)
    kpos_s = jnp.arange(past + Ts, dtype=jnp.int32)
    ksel_p = min(TOPK_MAX, Tp // 4)
    ksel_s = min(TOPK_MAX, (past + Ts) // 4)
    zero_left = jnp.zeros((Bp, POOL_STATE, POOL_WIDTH), x_prompt.dtype)

    xp, xs = x_prompt, x_sample
    kp, vp, kip, pp = [], [], [], []
    ksl, vsl, kisl, psl = [], [], [], []
    for l in range(DEPTH):
        wts = (norm_g[l], w_in[l], w_pool_mix[l], pool_scale[l], w_pool_out[l], w_attn_out[l], w_o[l])
        xp, k1, v1, ki1, p1 = layer(xp, pos_p, pos_p, None, None, None, zero_left, ksel_p, *wts)
        xs, k2, v2, ki2, p2 = layer(xs, pos_s, kpos_s, cache_k[l], cache_v[l], cache_kidx[l],
                                    state_pool[l], ksel_s, *wts)
        kp.append(k1); vp.append(v1); kip.append(ki1); pp.append(p1)
        ksl.append(k2); vsl.append(v2); kisl.append(ki2); psl.append(p2)

    y_prompt = rms_norm(xp, final_norm_g)
    y_sample = rms_norm(xs, final_norm_g)
    return (y_prompt, y_sample,
            jnp.stack(kp), jnp.stack(vp), jnp.stack(kip), jnp.stack(pp),
            jnp.stack(ksl), jnp.stack(vsl), jnp.stack(kisl), jnp.stack(psl))
```

```cpp
#include <hip/hip_runtime.h>
#include <hip/hip_cooperative_groups.h>
#include <stdint.h>
#include <cstdio>
namespace cg = cooperative_groups;

#ifndef MULTI_LAUNCH
#define MULTI_LAUNCH 0
#endif

typedef unsigned short bf16_t;
typedef short bf16x8 __attribute__((ext_vector_type(8)));
typedef short s16x4 __attribute__((ext_vector_type(4)));
typedef float f32x4 __attribute__((ext_vector_type(4)));
typedef float f32x2 __attribute__((ext_vector_type(2)));
typedef float f32x16 __attribute__((ext_vector_type(16)));
typedef unsigned u32x4 __attribute__((ext_vector_type(4)));
typedef unsigned u32x2 __attribute__((ext_vector_type(2)));
#define DI __device__ __forceinline__
#ifndef PHASE_FN
#define PHASE_FN __device__ __forceinline__
#endif

constexpr int DM = 1024, NTP = 32768, NTS = 512, NTOK = NTP + NTS;
constexpr int TP = 2048, TS = 64, PAST = 4096, LS = PAST + TS;
constexpr int NCOL = 5416, NP = 5440, NSEG = 85, NTN = 43;
constexpr int MTILES = NTOK / 128;
constexpr int LDX = 1024 + 64;
constexpr float QSCALE = 0.125f * 1.4426950408889634f;

constexpr size_t O_YP = 0;
constexpr size_t O_YS = O_YP + (size_t)NTP * DM;
constexpr size_t O_KP = O_YS + (size_t)NTS * DM;
constexpr size_t O_VP = O_KP + 2ull * 16 * TP * 512;
constexpr size_t O_KIP = O_VP + 2ull * 16 * TP * 512;
constexpr size_t O_PP = O_KIP + 2ull * 16 * TP * 32;
constexpr size_t O_KS = O_PP + 2ull * 16 * 15 * 512;
constexpr size_t O_VS = O_KS + 2ull * 8 * TS * 512;
constexpr size_t O_KIS = O_VS + 2ull * 8 * TS * 512;
constexpr size_t O_PS = O_KIS + 2ull * 8 * TS * 32;
constexpr size_t O_END = O_PS + 2ull * 8 * 15 * 512;

constexpr size_t al(size_t x) { return (x + 255) & ~size_t(255); }
constexpr size_t W_WIN = 0;
constexpr size_t W_WMIX = W_WIN + al(2ull * NP * 1024 * 2);
constexpr size_t W_WPO = W_WMIX + al(2ull * 4 * 128 * 128 * 2);
constexpr size_t W_WAO = W_WPO + al(2ull * 1024 * 512 * 2);
constexpr size_t W_WO = W_WAO + al(2ull * 1024 * 512 * 2);
constexpr size_t W_R64 = W_WO + al(2ull * 1024 * LDX * 2);
constexpr size_t W_R32 = W_R64 + al((size_t)LS * 32 * 8);
constexpr size_t W_XB = W_R32 + al((size_t)LS * 16 * 8);
constexpr size_t W_POOLED = W_XB;
constexpr size_t W_MASKP = W_XB + al((size_t)NTOK * 512 * 2);
constexpr size_t W_MASKS = W_MASKP + al((size_t)NTP * 64 * 4);
constexpr size_t W_SS = W_XB + al((size_t)NTOK * 1024 * 2);
static_assert(W_MASKS + (size_t)NTS * 192 * 4 <= W_SS, "mask alias overflow");
constexpr size_t W_U = W_SS + al((size_t)NTOK * 16 * 4);
constexpr size_t W_Q = W_U + (size_t)NTOK * 512 * 2;
constexpr size_t W_MERGED = W_U;
static_assert((size_t)NTOK * LDX * 2 <= 3 * (size_t)NTOK * 512 * 2, "MERGED alias overflow");
constexpr size_t W_ZP = W_Q + al((size_t)NTOK * 512 * 2);
constexpr size_t W_KP = W_ZP + al((size_t)NTOK * 512 * 2);
constexpr size_t W_VTP = W_KP + al(16ull * TP * 512 * 2);
constexpr size_t W_KS = W_VTP + al(16ull * TP * 512 * 2);
constexpr size_t W_VTS = W_KS + al(8ull * LS * 512 * 2);
constexpr size_t W_QI = W_VTS + al(8ull * LS * 512 * 2);
constexpr size_t W_KIP = W_QI + al((size_t)NTOK * 256 * 2);
constexpr size_t W_KIS = W_KIP + al(16ull * TP * 32 * 2);
constexpr size_t W_WI = W_KIS + al(2ull * 8 * LS * 32 * 2);
constexpr size_t W_ZA = W_WI + al((size_t)NTOK * 8 * 4);
constexpr size_t W_GP = W_ZA + al((size_t)NTOK * 512 * 2);
constexpr size_t W_GA = W_GP + al((size_t)NTOK * 1024);
constexpr size_t W_BAR = W_GA + al((size_t)NTOK * 1024);
constexpr size_t W_END = W_BAR + 32768;

struct P {
  const float *x_p, *x_s, *cache_k, *cache_v, *cache_ki, *state_pool, *norm_g, *w_in, *w_mix, *pool_scale, *w_po, *w_ao, *w_o, *final_g;
  float* out;
  char* ws;
};

constexpr int EPS = 132;
constexpr int RR_OFF = 128 * EPS * 4;
constexpr int LDS_BYTES = RR_OFF + 512;

DI int tidx() { int t = __builtin_amdgcn_workitem_id_x(); asm volatile("" : "+v"(t)); return t; }
DI float bf2f(bf16_t b) { return __uint_as_float(((unsigned)b) << 16); }
DI unsigned pk2(float lo, float hi) { unsigned r; asm("v_cvt_pk_bf16_f32 %0, %1, %2" : "=v"(r) : "v"(lo), "v"(hi)); return r; }
DI bf16_t f2bf(float x) { return (bf16_t)(pk2(x, 0.f) & 0xffffu); }
DI float sigmoidf_(float v) { return 1.f / (1.f + __expf(-v)); }
DI float siluf_(float v) { return v / (1.f + __expf(-v)); }
DI float wave_sum(float v) {
#pragma unroll
  for (int o = 1; o < 64; o <<= 1) v += __shfl_xor(v, o);
  return v;
}
#define MFMA16(a, b, c) __builtin_amdgcn_mfma_f32_16x16x32_bf16((a), (b), (c), 0, 0, 0)
#define MFMA32(a, b, c) __builtin_amdgcn_mfma_f32_32x32x16_bf16((a), (b), (c), 0, 0, 0)

DI void gemm_tile(const bf16_t* __restrict__ A, int lda, const bf16_t* __restrict__ Bt, int ldb, int bvalid, int K, f32x4 (&acc)[4][4], char* lds, bool preloaded = false) {
  const int tid = tidx(), lane = tid & 63, wave = __builtin_amdgcn_readfirstlane(tid >> 6);
  const int wm = wave >> 1, wn = wave & 1;
  const int lr = tid >> 3, lc = tid & 7;
  const int fr = lane & 15, fq = lane >> 4;
  const int fx = (fr >> 1) & 7;
  const bf16_t* ap = A + (size_t)lr * lda + ((lc ^ ((lr >> 1) & 7)) << 3);
  const bf16_t* bp = Bt + ((lc ^ ((lr >> 1) & 7)) << 3);
  typedef __attribute__((address_space(1))) const unsigned gptr_t;
  typedef __attribute__((address_space(3))) unsigned lptr_t;
  const unsigned lbase = (unsigned)(size_t)lds + (unsigned)tid * 16u;
#define GLDS(st, k0)                                                                                                             \
  _Pragma("unroll") for (int i = 0; i < 4; ++i) {                                                                                \
    __builtin_amdgcn_global_load_lds((gptr_t*)(ap + (size_t)(32 * i) * lda + (k0)), (lptr_t*)(lbase + (st) * 32768 + i * 4096), 16, 0, 0);          \
    __builtin_amdgcn_global_load_lds((gptr_t*)(bp + (size_t)((lr + 32 * i) & (bvalid - 1)) * ldb + (k0)), (lptr_t*)(lbase + (st) * 32768 + 16384 + i * 4096), 16, 0, 0); \
  }
  auto compute = [&](int st) {
    const char* base = lds + st * 32768;
    bf16x8 af[2][4], bfr[2][4];
#pragma unroll
    for (int s = 0; s < 2; ++s) {
      const int ch = ((4 * s + fq) ^ fx) << 4;
#pragma unroll
      for (int mi = 0; mi < 4; ++mi) af[s][mi] = *(const bf16x8*)(base + (wm * 64 + mi * 16 + fr) * 128 + ch);
#pragma unroll
      for (int ni = 0; ni < 4; ++ni) bfr[s][ni] = *(const bf16x8*)(base + 16384 + (wn * 64 + ni * 16 + fr) * 128 + ch);
    }
    __builtin_amdgcn_s_setprio(1);
#pragma unroll
    for (int s = 0; s < 2; ++s)
#pragma unroll
      for (int mi = 0; mi < 4; ++mi)
#pragma unroll
        for (int ni = 0; ni < 4; ++ni) acc[mi][ni] = MFMA16(af[s][mi], bfr[s][ni], acc[mi][ni]);
    __builtin_amdgcn_s_setprio(0);
  };
  const int nk = K >> 6;
  if (!preloaded) { GLDS(0, 0) }
  __syncthreads();
  for (int kt = 0; kt < nk; ++kt) {
    if (kt + 1 < nk) { GLDS((kt + 1) & 1, (kt + 1) << 6) }
    compute(kt & 1);
    __syncthreads();
  }
#undef GLDS
}

DI void gemm_prefetch0(const bf16_t* __restrict__ A, int lda, const bf16_t* __restrict__ Bt, int ldb, int bvalid, char* lds) {
  const int tid = tidx();
  const int lr = tid >> 3, lc = tid & 7;
  const bf16_t* ap = A + (size_t)lr * lda + ((lc ^ ((lr >> 1) & 7)) << 3);
  const bf16_t* bp = Bt + ((lc ^ ((lr >> 1) & 7)) << 3);
  typedef __attribute__((address_space(1))) const unsigned gptr_t;
  typedef __attribute__((address_space(3))) unsigned lptr_t;
  const unsigned lbase = (unsigned)(size_t)lds + (unsigned)tid * 16u;
#pragma unroll
  for (int i = 0; i < 4; ++i) {
    __builtin_amdgcn_global_load_lds((gptr_t*)(ap + (size_t)(32 * i) * lda), (lptr_t*)(lbase + i * 4096), 16, 0, 0);
    __builtin_amdgcn_global_load_lds((gptr_t*)(bp + (size_t)((lr + 32 * i) & (bvalid - 1)) * ldb), (lptr_t*)(lbase + 16384 + i * 4096), 16, 0, 0);
  }
}

DI void zero_acc(f32x4 (&acc)[4][4]) {
#pragma unroll
  for (int i = 0; i < 4; ++i)
#pragma unroll
    for (int j = 0; j < 4; ++j) acc[i][j] = f32x4{0.f, 0.f, 0.f, 0.f};
}


DI void stage_acc(const f32x4 (&acc)[4][4], float* tile, int wm, int wn, int fr, int fq) {
#pragma unroll
  for (int mi = 0; mi < 4; ++mi)
#pragma unroll
    for (int ni = 0; ni < 4; ++ni)
#pragma unroll
      for (int j = 0; j < 4; ++j) tile[(wm * 64 + mi * 16 + fq * 4 + j) * EPS + wn * 64 + ni * 16 + fr] = acc[mi][ni][j];
}
DI float row16_sum(float v) {
  v += __builtin_bit_cast(float, __builtin_amdgcn_update_dpp(0, __builtin_bit_cast(int, v), 0xB1, 0xf, 0xf, true));
  v += __builtin_bit_cast(float, __builtin_amdgcn_update_dpp(0, __builtin_bit_cast(int, v), 0x4E, 0xf, 0xf, true));
  v += __builtin_bit_cast(float, __builtin_amdgcn_update_dpp(0, __builtin_bit_cast(int, v), 0x141, 0xf, 0xf, true));
  v += __builtin_bit_cast(float, __builtin_amdgcn_update_dpp(0, __builtin_bit_cast(int, v), 0x140, 0xf, 0xf, true));
  return v;
}


struct XcdWalk {
  int MT, NT, x, mx, total, L, step;
  DI void init(int MT_, int NT_) {
    MT = MT_; NT = NT_;
    const int nb = gridDim.x >> 3;
    if ((gridDim.x & 7) == 0 && nb > 0) { x = blockIdx.x & 7; L = blockIdx.x >> 3; step = nb; mx = (MT - x + 7) >> 3; total = mx * NT; }
    else { x = -1; L = blockIdx.x; step = gridDim.x; mx = MT; total = MT * NT; }
  }
  DI bool next(int& mt, int& nt) {
    if (L >= total) return false;
    if (x < 0) { mt = L / NT; nt = L % NT; L += step; return true; }
    const int colsz = mx * 8;
    const int nfull = NT >> 3;
    int ng = L / colsz, gn = 8;
    if (ng >= nfull) { ng = nfull; gn = NT & 7; }
    const int Lp = L - ng * colsz;
    const int mg = Lp / (8 * gn), r = Lp - mg * 8 * gn;
    const int rows = (mx - 8 * mg) < 8 ? (mx - 8 * mg) : 8;
    const int lm = r / gn, ln = r - lm * gn;
    mt = (8 * mg + lm) * 8 + x; nt = ng * 8 + ln;
    L += step;
    return true;
  }
};

DI void tr_item(const float* __restrict__ src, int ldsrc, int k0, int n0, bf16_t* __restrict__ dst, int K, const float* __restrict__ gs, bool winmap, float* tile) {
  const int tid = tidx();
  const int kk = tid >> 4, n4 = (tid & 15) * 4;
#pragma unroll
  for (int i = 0; i < 4; ++i) {
    const int k = k0 + kk + 16 * i;
    const int nd = n0 + n4;
    int sn = nd;
    if (winmap) sn = (nd < 2856) ? nd : ((nd < 2880) ? -1 : nd - 24);
    f32x4 v = {0.f, 0.f, 0.f, 0.f};
    if (sn >= 0) v = __builtin_nontemporal_load((const f32x4*)(src + (size_t)k * ldsrc + sn));
    if (gs) { const float g = gs[k]; v *= g; }
    float* t = tile + (kk + 16 * i) * 65 + n4;
    t[0] = v.x; t[1] = v.y; t[2] = v.z; t[3] = v.w;
  }
  __syncthreads();
  const int n = tid >> 2, kc = tid & 3;
  unsigned o[8];
#pragma unroll
  for (int e = 0; e < 8; ++e) o[e] = pk2(tile[(kc * 16 + 2 * e) * 65 + n], tile[(kc * 16 + 2 * e + 1) * 65 + n]);
  bf16_t* d = dst + (size_t)(n0 + n) * K + k0 + kc * 16;
  *(u32x4*)d = u32x4{o[0], o[1], o[2], o[3]};
  *(u32x4*)(d + 8) = u32x4{o[4], o[5], o[6], o[7]};
  __syncthreads();
}

DI void conv_cache_k(const P& p, int layer, int it) {
  const size_t e0 = ((size_t)it * 256 + tidx()) * 8;
  const int b = (int)(e0 / (4096ull * 512)), rem = (int)(e0 % (4096ull * 512));
  const float* s = p.cache_k + (size_t)layer * 8 * 4096 * 512 + e0;
  const f32x4 v0 = __builtin_nontemporal_load((const f32x4*)s), v1 = __builtin_nontemporal_load((const f32x4*)(s + 4));
  bf16_t* d = (bf16_t*)(p.ws + W_KS) + (size_t)b * LS * 512 + rem;
  *(u32x4*)d = u32x4{pk2(v0.x, v0.y), pk2(v0.z, v0.w), pk2(v1.x, v1.y), pk2(v1.z, v1.w)};
}
DI void conv_cache_v(const P& p, int layer, int it) {
  const int kg = it & 127, h = (it >> 7) & 7, b = it >> 10;
  const int d = tidx() & 63, ko = tidx() >> 6;
  const int key0 = kg * 32 + ko * 8;
  const float* s = p.cache_v + (size_t)layer * 8 * 4096 * 512 + ((size_t)(b * 4096 + key0) * 8 + h) * 64 + d;
  float v[8];
#pragma unroll
  for (int e = 0; e < 8; ++e) v[e] = __builtin_nontemporal_load(s + (size_t)e * 512);
  bf16_t* dst = (bf16_t*)(p.ws + W_VTS) + ((size_t)(b * 8 + h) * 64 + d) * LS + (key0 & ~15) + ((key0 & 8) >> 1);
  *(u32x2*)dst = u32x2{pk2(v[0], v[1]), pk2(v[2], v[3])};
  *(u32x2*)(dst + 8) = u32x2{pk2(v[4], v[5]), pk2(v[6], v[7])};
}
DI void conv_cache_ki(const P& p, int it) {
  const size_t e0 = ((size_t)it * 256 + tidx()) * 8;
  const int lb = (int)(e0 / (4096ull * 32)), rem = (int)(e0 % (4096ull * 32));
  const float* s = p.cache_ki + e0;
  const f32x4 v0 = *(const f32x4*)s, v1 = *(const f32x4*)(s + 4);
  bf16_t* d = (bf16_t*)(p.ws + W_KIS) + (size_t)lb * LS * 32 + rem;
  *(u32x4*)d = u32x4{pk2(v0.x, v0.y), pk2(v0.z, v0.w), pk2(v1.x, v1.y), pk2(v1.z, v1.w)};
}

DI void rope_item(const P& p, int it) {
  const int e = it * 256 + tidx();
  if (e >= LS * 48) return;
  const int pos = e / 48, i = e % 48;
  float inv;
  if (i < 32) inv = exp2f(-(float)(2 * i) / 64.f * 13.287712379549449f);
  else inv = exp2f(-(float)(2 * (i - 32)) / 32.f * 13.287712379549449f);
  const float ang = (float)pos * inv;
  const float n = rintf(ang * 0.15915494309189535f);
  float r = fmaf(-n, 6.28125f, ang);
  r = fmaf(-n, 1.9353071795864769e-3f, r);
  const float c = cosf(r), s = sinf(r);
  f32x2* dst = (i < 32) ? ((f32x2*)(p.ws + W_R64) + pos * 32 + i) : ((f32x2*)(p.ws + W_R32) + pos * 16 + (i - 32));
  *dst = f32x2{c, s};
}

DI void xconv_item(const P& p, int it) {
  const int lane = tidx() & 63, wave = __builtin_amdgcn_readfirstlane(tidx() >> 6);
  const int row = it * 4 + wave;
  const float* x = (row < NTP) ? (p.x_p + (size_t)row * DM) : (p.x_s + (size_t)(row - NTP) * DM);
  bf16_t* xb = (bf16_t*)(p.ws + W_XB) + (size_t)row * DM;
  float ss = 0.f;
#pragma unroll
  for (int j = 0; j < 4; ++j) {
    const f32x4 v = *(const f32x4*)(x + j * 256 + lane * 4);
    ss += v.x * v.x + v.y * v.y + v.z * v.z + v.w * v.w;
    *(u32x2*)(xb + j * 256 + lane * 4) = u32x2{pk2(v.x, v.y), pk2(v.z, v.w)};
  }
  ss = wave_sum(ss);
  if (lane < 16) ((float*)(p.ws + W_SS))[(size_t)row * 16 + lane] = (lane == 0) ? ss : 0.f;
}

constexpr int NWITEM = 16 * 85 + 128 + 128 + 256 + 16;
DI void weight_item(const P& p, int l, int idx, float* tile) {
  if (idx < 16 * 85) {
    const int kt = idx / 85, nt = idx % 85;
    tr_item(p.w_in + (size_t)l * 1024 * NCOL, NCOL, kt * 64, nt * 64, (bf16_t*)(p.ws + W_WIN) + (size_t)l * NP * 1024, 1024, p.norm_g + l * 1024, true, tile);
  } else if (idx < 16 * 85 + 128) {
    const int r = idx - 16 * 85, kt = r / 16, nt = r % 16;
    tr_item(p.w_po + (size_t)l * 512 * 1024, 1024, kt * 64, nt * 64, (bf16_t*)(p.ws + W_WPO) + (size_t)l * 1024 * 512, 512, nullptr, false, tile);
  } else if (idx < 16 * 85 + 256) {
    const int r = idx - 16 * 85 - 128, kt = r / 16, nt = r % 16;
    tr_item(p.w_ao + (size_t)l * 512 * 1024, 1024, kt * 64, nt * 64, (bf16_t*)(p.ws + W_WAO) + (size_t)l * 1024 * 512, 512, nullptr, false, tile);
  } else if (idx < 16 * 85 + 512) {
    const int r = idx - 16 * 85 - 256, kt = r / 16, nt = r % 16;
    tr_item(p.w_o + (size_t)l * 1024 * 1024, 1024, kt * 64, nt * 64, (bf16_t*)(p.ws + W_WO) + (size_t)l * 1024 * LDX, LDX, nullptr, false, tile);
  } else {
    const int r0 = idx - 16 * 85 - 512, g = r0 / 4, r = r0 % 4, kt = r / 2, nt = r % 2;
    tr_item(p.w_mix + (size_t)(l * 4 + g) * 128 * 128, 128, kt * 64, nt * 64, (bf16_t*)(p.ws + W_WMIX) + (size_t)(l * 4 + g) * 128 * 128, 128, nullptr, false, tile);
  }
}

PHASE_FN void phase0(const P& p, char* lds) {
  float* tile = (float*)lds;
  constexpr int R4 = NWITEM, R5 = R4 + 8320, R6 = R5 + 780, R9 = R6 + 1024;
  for (int it = blockIdx.x; it < R9; it += gridDim.x) {
    if (it < R4) weight_item(p, 0, it, tile);
    else if (it < R5) xconv_item(p, it - R4);
    else if (it < R6) rope_item(p, it - R5);
    else conv_cache_ki(p, it - R6);
  }
}

DI void phaseA_tile(const P& p, int layer, int mt, int nt, char* lds) {
  const int tid = tidx(), lane = tid & 63, wave = __builtin_amdgcn_readfirstlane(tid >> 6);
  const int row0 = mt * 128, col0 = nt * 128;
  const int bvalid = (NP - col0) < 128 ? 64 : 128;
  float* rr = (float*)(lds + RR_OFF);
  __syncthreads();
  const float* sp = (const float*)(p.ws + W_SS) + (size_t)(row0 + (tid & 127)) * 16;
  const f32x4 ssa = *(const f32x4*)sp, ssb = *(const f32x4*)(sp + 4), ssc = *(const f32x4*)(sp + 8), ssd = *(const f32x4*)(sp + 12);
  f32x4 acc[4][4];
  zero_acc(acc);
  gemm_tile((const bf16_t*)(p.ws + W_XB) + (size_t)row0 * DM, DM, (const bf16_t*)(p.ws + W_WIN) + ((size_t)layer * NP + col0) * 1024, 1024, bvalid, 1024, acc, lds);
  const int wm = wave >> 1, wn = wave & 1;
  const int seg = (col0 >> 6) + wn;
  const int fr = lane & 15, fq = lane >> 4;
  if (tid < 128) {
    const float ss = (ssa.x + ssa.y + ssa.z + ssa.w) + (ssb.x + ssb.y + ssb.z + ssb.w) + (ssc.x + ssc.y + ssc.z + ssc.w) + (ssd.x + ssd.y + ssd.z + ssd.w);
    rr[tid] = rsqrtf(ss * (1.f / 1024.f) + 1e-6f);
  }
  float* stg = (float*)lds;
  stage_acc(acc, stg, wm, wn, fr, fq);
  __syncthreads();
  if (seg >= NSEG) return;
  float* out = p.out;
  const bool isS = row0 >= NTP;
  if (seg >= 53) {
    const bool isP = seg < 69;
    unsigned* G = (unsigned*)(p.ws + (isP ? W_GP : W_GA)) + ((size_t)(((row0 >> 6) + wm) * 16 + (isP ? seg - 53 : seg - 69)) * 64 + lane) * 16;
#pragma unroll
    for (int mi = 0; mi < 4; ++mi) {
      unsigned wv[4];
#pragma unroll
      for (int ni = 0; ni < 4; ++ni) {
        unsigned w_ = 0u;
#pragma unroll
        for (int j = 0; j < 4; ++j) {
          const float r = rr[wm * 64 + mi * 16 + fq * 4 + j];
          w_ |= ((unsigned)(int)(sigmoidf_(acc[mi][ni][j] * r) * 255.f + 0.5f)) << (8 * j);
        }
        wv[ni] = w_;
      }
      *(u32x4*)(G + mi * 4) = u32x4{wv[0], wv[1], wv[2], wv[3]};
    }
    return;
  }
  if (seg >= 32 && seg < 40) {
    const int h = seg - 32;
    const int wrow0 = row0 + wm * 64;
    const int bb = isS ? ((wrow0 - NTP) >> 6) : (wrow0 >> 11);
    const int tb = isS ? 0 : (wrow0 & 2047);
#pragma unroll
    for (int mi = 0; mi < 4; ++mi) {
      const int lr0 = mi * 16 + fq * 4, t0 = tb + mi * 16 + ((((fq & 1) << 1) | (fq >> 1)) << 2);
      const f32x4 r4 = *(const f32x4*)(rr + wm * 64 + lr0);
#pragma unroll
      for (int ni = 0; ni < 4; ++ni) {
        const int d = ni * 16 + fr;
        const f32x4 v = acc[mi][ni] * r4;
        bf16_t* vt = isS ? (bf16_t*)(p.ws + W_VTS) + ((size_t)(bb * 8 + h) * 64 + d) * LS + PAST + t0 : (bf16_t*)(p.ws + W_VTP) + ((size_t)(bb * 8 + h) * 64 + d) * TP + t0;
        *(u32x2*)vt = u32x2{pk2(v.x, v.y), pk2(v.z, v.w)};
      }
    }
  }
  const int cc = lane & 15;
  const bool rope64 = seg >= 16 && seg < 32, rope32 = seg >= 40 && seg <= 44;
  if (rope64 || rope32) {
    const int pair = rope64 ? 8 : 4, fmask = rope64 ? 7 : 3;
    const float* RT = (const float*)(p.ws + (rope64 ? W_R64 : W_R32));
    const int rstride = rope64 ? 32 : 16;
    const float sg = (cc & pair) ? 1.f : -1.f;
#pragma unroll 1
    for (int half = 0; half < 2; ++half) {
      f32x4 c0[8], c1[8];
#pragma unroll
      for (int pq = 0; pq < 8; ++pq) {
        const int row = row0 + (half * 8 + pq) * 8 + wm * 4 + fq;
        const int t = isS ? ((row - NTP) & 63) : (row & 2047);
        const float* cs = RT + ((size_t)(isS ? PAST + t : t) * rstride + (cc & fmask) * 4) * 2;
        c0[pq] = *(const f32x4*)cs; c1[pq] = *(const f32x4*)(cs + 4);
      }
#pragma unroll
      for (int pq = 0; pq < 8; ++pq) {
        const int lr = (half * 8 + pq) * 8 + wm * 4 + fq, row = row0 + lr;
        const float r = rr[lr];
        const float* tp = stg + lr * EPS + wn * 64;
        const f32x4 v = *(const f32x4*)(tp + cc * 4) * r;
        const f32x4 pv = *(const f32x4*)(tp + (cc ^ pair) * 4) * r;
        const int bb = isS ? ((row - NTP) >> 6) : (row >> 11);
        const int t = isS ? ((row - NTP) & 63) : (row & 2047);
        f32x4 o;
        o.x = v.x * c0[pq].x + sg * pv.x * c0[pq].y; o.y = v.y * c0[pq].z + sg * pv.y * c0[pq].w;
        o.z = v.z * c1[pq].x + sg * pv.z * c1[pq].y; o.w = v.w * c1[pq].z + sg * pv.w * c1[pq].w;
        if (seg < 24) {
          *(u32x2*)((bf16_t*)(p.ws + W_Q) + (size_t)row * 512 + (seg - 16) * 64 + cc * 4) = u32x2{pk2(o.x * QSCALE, o.y * QSCALE), pk2(o.z * QSCALE, o.w * QSCALE)};
        } else if (seg < 32) {
          const int hc = (seg - 24) * 64 + cc * 4;
          float* ko = isS ? out + O_KS + ((size_t)(layer * 8 + bb) * TS + t) * 512 + hc : out + O_KP + ((size_t)(layer * 16 + bb) * TP + t) * 512 + hc;
          bf16_t* kb = isS ? (bf16_t*)(p.ws + W_KS) + ((size_t)bb * LS + PAST + t) * 512 + hc : (bf16_t*)(p.ws + W_KP) + ((size_t)bb * TP + t) * 512 + hc;
          __builtin_nontemporal_store(o, (f32x4*)ko);
          *(u32x2*)kb = u32x2{pk2(o.x, o.y), pk2(o.z, o.w)};
        } else if (seg < 44) {
          *(u32x2*)((bf16_t*)(p.ws + W_QI) + (size_t)row * 256 + (seg - 40) * 64 + cc * 4) = u32x2{pk2(o.x, o.y), pk2(o.z, o.w)};
        } else if (cc < 8) {
          float* ko = isS ? out + O_KIS + ((size_t)(layer * 8 + bb) * TS + t) * 32 + cc * 4 : out + O_KIP + ((size_t)(layer * 16 + bb) * TP + t) * 32 + cc * 4;
          bf16_t* kb = isS ? (bf16_t*)(p.ws + W_KIS) + ((size_t)(layer * 8 + bb) * LS + PAST + t) * 32 + cc * 4 : (bf16_t*)(p.ws + W_KIP) + ((size_t)bb * TP + t) * 32 + cc * 4;
          __builtin_nontemporal_store(o, (f32x4*)ko);
          *(u32x2*)kb = u32x2{pk2(o.x, o.y), pk2(o.z, o.w)};
        } else if (cc < 10) {
          *(f32x4*)((float*)(p.ws + W_WI) + (size_t)row * 8 + (cc - 8) * 4) = v * 0.0625f;
        }
      }
    }
    return;
  }
#pragma unroll 2
  for (int ps = 0; ps < 16; ++ps) {
    const int lr = ps * 8 + wm * 4 + fq, row = row0 + lr;
    const float r = rr[lr];
    const float* tp = stg + lr * EPS + wn * 64;
    const f32x4 v = *(const f32x4*)(tp + cc * 4) * r;
    const int bb = isS ? ((row - NTP) >> 6) : (row >> 11);
    const int t = isS ? ((row - NTP) & 63) : (row & 2047);
    if (seg < 8) {
      const int col = seg * 64 + cc * 4;
      *(u32x2*)((bf16_t*)(p.ws + W_U) + (size_t)row * 512 + col) = u32x2{pk2(v.x, v.y), pk2(v.z, v.w)};
      if (!isS) { if (t >= TP - 15) *(f32x4*)(out + O_PP + ((size_t)(layer * 16 + bb) * 15 + (t - (TP - 15))) * 512 + col) = v; }
      else { if (t >= TS - 15) *(f32x4*)(out + O_PS + ((size_t)(layer * 8 + bb) * 15 + (t - (TS - 15))) * 512 + col) = v; }
    } else if (seg < 16 || (seg >= 45 && seg < 53)) {
      bf16_t* Z = (bf16_t*)(p.ws + (seg < 16 ? W_ZP : W_ZA)) + (size_t)row * 512 + (seg < 16 ? seg - 8 : seg - 45) * 64 + cc * 4;
      *(u32x2*)Z = u32x2{pk2(siluf_(v.x), siluf_(v.y)), pk2(siluf_(v.z), siluf_(v.w))};
    } else {
      const int hc = (seg - 32) * 64 + cc * 4;
      float* vo = isS ? out + O_VS + ((size_t)(layer * 8 + bb) * TS + t) * 512 + hc : out + O_VP + ((size_t)(layer * 16 + bb) * TP + t) * 512 + hc;
      __builtin_nontemporal_store(v, (f32x4*)vo);
    }
  }
}


DI int next_ticket(unsigned* ctr, int* slot) {
  __syncthreads();
  if (__builtin_amdgcn_workitem_id_x() == 0) *slot = (int)__hip_atomic_fetch_add(ctr, 1u, __ATOMIC_RELAXED, __HIP_MEMORY_SCOPE_AGENT);
  __syncthreads();
  return *slot;
}

DI int wave_isum(int v) {
  v += __builtin_amdgcn_update_dpp(0, v, 0xB1, 0xf, 0xf, true);
  v += __builtin_amdgcn_update_dpp(0, v, 0x4E, 0xf, 0xf, true);
  v += __builtin_amdgcn_update_dpp(0, v, 0x141, 0xf, 0xf, true);
  v += __builtin_amdgcn_update_dpp(0, v, 0x140, 0xf, 0xf, true);
  return __builtin_amdgcn_readlane(v, 0) + __builtin_amdgcn_readlane(v, 16) + __builtin_amdgcn_readlane(v, 32) + __builtin_amdgcn_readlane(v, 48);
}

DI unsigned wave_umax(unsigned v) {
  unsigned t;
  t = (unsigned)__builtin_amdgcn_update_dpp(0, (int)v, 0xB1, 0xf, 0xf, true); v = t > v ? t : v;
  t = (unsigned)__builtin_amdgcn_update_dpp(0, (int)v, 0x4E, 0xf, 0xf, true); v = t > v ? t : v;
  t = (unsigned)__builtin_amdgcn_update_dpp(0, (int)v, 0x141, 0xf, 0xf, true); v = t > v ? t : v;
  t = (unsigned)__builtin_amdgcn_update_dpp(0, (int)v, 0x140, 0xf, 0xf, true); v = t > v ? t : v;
  const unsigned a = (unsigned)__builtin_amdgcn_readlane((int)v, 0), b = (unsigned)__builtin_amdgcn_readlane((int)v, 16);
  const unsigned c = (unsigned)__builtin_amdgcn_readlane((int)v, 32), d = (unsigned)__builtin_amdgcn_readlane((int)v, 48);
  const unsigned ab = a > b ? a : b, cd = c > d ? c : d;
  return ab > cd ? ab : cd;
}

template <bool SAMPLE>
DI void b1_score(const bf16_t* __restrict__ QI, const float* __restrict__ WI, const bf16_t* __restrict__ KI, int qrow0, int nt, float* sc, int pass) {
  const int lane = tidx() & 63, r = lane & 31, hl = lane >> 5;
  const int rp = r & 15, hq = (rp >> 2) & 1, head = (rp & 3) + 4 * (rp >> 3);
  const bf16_t* qa = QI + (size_t)(qrow0 + hq) * 256 + head * 32 + 8 * hl;
  const bf16x8 a0 = *(const bf16x8*)qa, a1 = *(const bf16x8*)(qa + 16);
  const float* wp = WI + (size_t)(qrow0 + hl) * 8;
  const f32x4 w0 = *(const f32x4*)wp, w1 = *(const f32x4*)(wp + 4);
  const bf16_t* kb = KI + (size_t)r * 32 + 8 * hl;
  bf16x8 c[4], n[4];
  c[0] = *(const bf16x8*)(kb); c[1] = *(const bf16x8*)(kb + 16); c[2] = *(const bf16x8*)(kb + 1024); c[3] = *(const bf16x8*)(kb + 1024 + 16);
  float* so = SAMPLE ? sc + r : sc + hl * 2048 + r;
  const int ng = nt >> 1;
#pragma unroll 1
  for (int g = 0; g < ng; ++g) {
    const int gn = (g + 1 < ng) ? g + 1 : g;
    const bf16_t* kn = kb + (size_t)gn * 2048;
    n[0] = *(const bf16x8*)(kn); n[1] = *(const bf16x8*)(kn + 16); n[2] = *(const bf16x8*)(kn + 1024); n[3] = *(const bf16x8*)(kn + 1024 + 16);
#pragma unroll
    for (int tt = 0; tt < 2; ++tt) {
      f32x16 acc;
#pragma unroll
      for (int i = 0; i < 16; ++i) acc[i] = 0.f;
      acc = MFMA32(a0, c[2 * tt], acc);
      acc = MFMA32(a1, c[2 * tt + 1], acc);
      float s_ = 0.f;
      s_ = fmaf(w0.x, fmaxf(acc[0], 0.f), s_); s_ = fmaf(w0.y, fmaxf(acc[1], 0.f), s_); s_ = fmaf(w0.z, fmaxf(acc[2], 0.f), s_); s_ = fmaf(w0.w, fmaxf(acc[3], 0.f), s_);
      s_ = fmaf(w1.x, fmaxf(acc[4], 0.f), s_); s_ = fmaf(w1.y, fmaxf(acc[5], 0.f), s_); s_ = fmaf(w1.z, fmaxf(acc[6], 0.f), s_); s_ = fmaf(w1.w, fmaxf(acc[7], 0.f), s_);
      if (!SAMPLE || hl == pass) so[(2 * g + tt) * 32] = s_;
    }
#pragma unroll
    for (int i = 0; i < 4; ++i) c[i] = n[i];
  }
}

template <bool SAMPLE>
DI void b1_score_coop(const bf16_t* __restrict__ QI, const float* __restrict__ WI, const bf16_t* __restrict__ KI, int qrow0, int nt, float* scb, int rowlen, int wave) {
  constexpr int NSET = SAMPLE ? 1 : 2;
  const int lane = tidx() & 63, r = lane & 31, hl = lane >> 5;
  const int rp = r & 15, hq = (rp >> 2) & 1, head = (rp & 3) + 4 * (rp >> 3), slr = r >> 4;
  bf16x8 a0[NSET], a1[NSET];
  float w[NSET][2][8];
#pragma unroll
  for (int s_ = 0; s_ < NSET; ++s_) {
    const bf16_t* qa = QI + (size_t)(qrow0 + 4 * s_ + 2 * slr + hq) * 256 + head * 32 + 8 * hl;
    a0[s_] = *(const bf16x8*)qa; a1[s_] = *(const bf16x8*)(qa + 16);
#pragma unroll
    for (int sl = 0; sl < 2; ++sl) {
      const float* wp = WI + (size_t)(qrow0 + 4 * s_ + 2 * sl + hl) * 8;
      const f32x4 w0 = *(const f32x4*)wp, w1 = *(const f32x4*)(wp + 4);
      w[s_][sl][0] = w0.x; w[s_][sl][1] = w0.y; w[s_][sl][2] = w0.z; w[s_][sl][3] = w0.w;
      w[s_][sl][4] = w1.x; w[s_][sl][5] = w1.y; w[s_][sl][6] = w1.z; w[s_][sl][7] = w1.w;
    }
  }
  const bf16_t* kb = KI + (size_t)r * 32 + 8 * hl;
  const int ng = nt >> 1;
  bf16x8 c[4], n[4];
  if (wave < ng) { const bf16_t* k0 = kb + (size_t)wave * 2048; c[0] = *(const bf16x8*)(k0); c[1] = *(const bf16x8*)(k0 + 16); c[2] = *(const bf16x8*)(k0 + 1024); c[3] = *(const bf16x8*)(k0 + 1024 + 16); }
#pragma unroll 1
  for (int g = wave; g < ng; g += 4) {
    const int gn = (g + 4 < ng) ? g + 4 : g;
    const bf16_t* kn = kb + (size_t)gn * 2048;
    n[0] = *(const bf16x8*)(kn); n[1] = *(const bf16x8*)(kn + 16); n[2] = *(const bf16x8*)(kn + 1024); n[3] = *(const bf16x8*)(kn + 1024 + 16);
#pragma unroll
    for (int tt = 0; tt < 2; ++tt)
#pragma unroll
      for (int s_ = 0; s_ < NSET; ++s_) {
        f32x16 acc;
#pragma unroll
        for (int i = 0; i < 16; ++i) acc[i] = 0.f;
        acc = MFMA32(a0[s_], c[2 * tt], acc);
        acc = MFMA32(a1[s_], c[2 * tt + 1], acc);
#pragma unroll
        for (int sl = 0; sl < 2; ++sl) {
          float x0 = 0.f, x1 = 0.f;
#pragma unroll
          for (int i = 0; i < 4; ++i) { x0 = fmaf(w[s_][sl][i], fmaxf(acc[8 * sl + i], 0.f), x0); x1 = fmaf(w[s_][sl][4 + i], fmaxf(acc[8 * sl + 4 + i], 0.f), x1); }
          scb[(4 * s_ + 2 * sl + hl) * rowlen + (2 * g + tt) * 32 + r] = x0 + x1;
        }
      }
#pragma unroll
    for (int i = 0; i < 4; ++i) c[i] = n[i];
  }
}

template <int NJ>
DI void b1_select(const float* sc, int nj, unsigned* mo) {
  const int lane = tidx() & 63;
  unsigned key[NJ];
#pragma unroll
  for (int j = 0; j < NJ; ++j) {
    unsigned k = 0u;
    if (j < nj) {
      unsigned u = __float_as_uint(sc[64 * j + lane]);
      u = (u == 0x80000000u) ? 0u : u;
      k = (u & 0x80000000u) ? ~u : (u | 0x80000000u);
    }
    key[j] = k;
  }
  unsigned mloc = 0u;
#pragma unroll
  for (int j = 0; j < NJ; ++j) mloc = key[j] > mloc ? key[j] : mloc;
  const unsigned M = wave_umax(mloc);
  unsigned T = 0u;
  int bit = 31;
  bool exact = false;
  {
    unsigned E = M >> 23;
#pragma unroll 1
    for (int i = 0; i < 8; ++i) {
      const unsigned cand = E << 23;
      int c0 = 0, c1 = 0;
#pragma unroll
      for (int j = 0; j < NJ; ++j) { if (j & 1) c1 += (key[j] >= cand) ? 1 : 0; else c0 += (key[j] >= cand) ? 1 : 0; }
      const int cnt = wave_isum(c0 + c1);
      if (cnt >= 256) { T = cand; bit = 22; exact = (cnt == 256); break; }
      if (E == 0u) break;
      --E;
    }
  }
  if (!exact) {
#pragma unroll 1
    for (; bit >= 0; --bit) {
      const unsigned cand = T | (1u << bit);
      int c0 = 0, c1 = 0;
#pragma unroll
      for (int j = 0; j < NJ; ++j) { if (j & 1) c1 += (key[j] >= cand) ? 1 : 0; else c0 += (key[j] >= cand) ? 1 : 0; }
      const int cnt = wave_isum(c0 + c1);
      if (cnt >= 256) { T = cand; if (cnt == 256) break; }
    }
  }
  int cgt = 0;
#pragma unroll
  for (int j = 0; j < NJ; ++j) cgt += __popcll(__ballot(key[j] > T));
  const int need = 256 - cgt;
  const unsigned long long lm = (1ull << lane) - 1ull;
  int run = 0;
  unsigned long long w0 = 0ull, w1 = 0ull;
#pragma unroll
  for (int j = 0; j < NJ; ++j) {
    const bool e = key[j] == T;
    const unsigned long long me = __ballot(e);
    const int before = run + __popcll(me & lm);
    const bool sel = (key[j] > T) || (e && before < need);
    run += __popcll(me);
    const unsigned long long ms = __ballot(sel);
    if (j < 64) w0 = (lane == j) ? ms : w0; else w1 = (lane == j - 64) ? ms : w1;
  }
  if (NJ >= 64 || lane < NJ) *(u32x2*)(mo + 2 * lane) = u32x2{(unsigned)w0, (unsigned)(w0 >> 32)};
  if (NJ > 64 && lane < NJ - 64) *(u32x2*)(mo + 128 + 2 * lane) = u32x2{(unsigned)w1, (unsigned)(w1 >> 32)};
}

DI void pooled_item(const P& p, int layer, int it) {
  const int row = it * 4 + __builtin_amdgcn_readfirstlane(tidx() >> 6), c0 = (tidx() & 63) * 8;
  const int g = c0 >> 7, w = 2 << g;
  const bool isS = row >= NTP;
  const int b = isS ? ((row - NTP) >> 6) : (row >> 11), t = isS ? ((row - NTP) & 63) : (row & 2047);
  const bf16_t* U = (const bf16_t*)(p.ws + W_U);
  u32x4 uv[16];
#pragma unroll
  for (int j = 0; j < 16; ++j) {
    uv[j] = u32x4{0u, 0u, 0u, 0u};
    if (j < w && t - j >= 0) uv[j] = *(const u32x4*)(U + (size_t)(row - j) * 512 + c0);
  }
  float s[8];
#pragma unroll
  for (int e = 0; e < 8; ++e) s[e] = 0.f;
#pragma unroll
  for (int j = 0; j < 16; ++j)
#pragma unroll
    for (int e = 0; e < 4; ++e) { s[2 * e] += __uint_as_float(uv[j][e] << 16); s[2 * e + 1] += __uint_as_float(uv[j][e] & 0xffff0000u); }
  if (isS && t < 15) {
    for (int j = t + 1; j < w; ++j) {
      const float* lp = p.state_pool + ((size_t)(layer * 8 + b) * 15 + (15 + t - j)) * 512 + c0;
      const f32x4 v0 = *(const f32x4*)lp, v1 = *(const f32x4*)(lp + 4);
      s[0] += v0.x; s[1] += v0.y; s[2] += v0.z; s[3] += v0.w; s[4] += v1.x; s[5] += v1.y; s[6] += v1.z; s[7] += v1.w;
    }
  }
  const float inv = 1.f / (float)(isS ? w : ((t + 1) < w ? (t + 1) : w));
  unsigned o[4];
#pragma unroll
  for (int e = 0; e < 4; ++e) o[e] = pk2(s[2 * e] * inv - __uint_as_float(uv[0][e] << 16), s[2 * e + 1] * inv - __uint_as_float(uv[0][e] & 0xffff0000u));
  *(u32x4*)((bf16_t*)(p.ws + W_POOLED) + (size_t)row * 512 + c0) = u32x4{o[0], o[1], o[2], o[3]};
}

PHASE_FN void phaseB(const P& p, int layer, char* lds) {
  constexpr int NB1S = 128, NB1P = 4096, NPG = 8320 / 8, NCK = 8192 / 8, NCV = 8192 / 8, NWG = NWITEM / 8;
  static_assert(NWITEM % 8 == 0 && NPG + NCK + NCV + NWG <= NB1P, "interleave assumes fewer misc groups than prompt items");
  const int NMISC = NPG + NCK + NCV + (layer == 0 ? NWG : 0);
  const int NTICK = NB1S + 2 * NMISC + (NB1P - NMISC);
  const int wave = __builtin_amdgcn_readfirstlane(tidx() >> 6), lane = tidx() & 63;
  float* scb = (float*)lds;
  const bf16_t* QI = (const bf16_t*)(p.ws + W_QI);
  const float* WI = (const float*)(p.ws + W_WI);
  unsigned* ctr = (unsigned*)(p.ws + W_BAR) + 3520 + layer * 64;
  int* slot = (int*)(lds + RR_OFF + 496);
  for (;;) {
    const int it = next_ticket(ctr, slot);
    if (it >= NTICK) break;
    int pi = -1, mi = -1;
    if (it >= NB1S) {
      const int t = it - NB1S;
      if (t < 2 * NMISC) { if (t & 1) mi = t >> 1; else pi = t >> 1; }
      else pi = t - NMISC;
    }
    if (it < NB1S) {
      const int srow = 4 * it, b = srow >> 6;
      const bf16_t* KI = (const bf16_t*)(p.ws + W_KIS) + (size_t)(layer * 8 + b) * LS * 32;
      b1_score_coop<true>(QI, WI, KI, NTP + srow, 130, scb, LS, wave);
      __syncthreads();
      b1_select<65>(scb + wave * LS, 65, (unsigned*)(p.ws + W_MASKS) + (size_t)(srow + wave) * 192);
    } else if (pi >= 0) {
      const int i0 = pi * 4;
      const int chunk = 31 - (i0 >> 9), b = (i0 & 511) >> 5, sub0 = i0 & 31;
      const int row0 = b * TP + chunk * 64 + sub0 * 2, row = row0 + 2 * wave, nt = 2 * (chunk + 1);
      unsigned* mo = (unsigned*)(p.ws + W_MASKP) + (size_t)row * 64;
      if (nt * 32 <= 256) {
        if (lane < 32) {
          const unsigned v = (lane < (nt >> 1)) ? 0xffffffffu : 0u;
          *(u32x2*)(mo + 2 * lane) = u32x2{v, v};
          *(u32x2*)(mo + 64 + 2 * lane) = u32x2{v, v};
        }
      } else {
        b1_score_coop<false>(QI, WI, (const bf16_t*)(p.ws + W_KIP) + (size_t)b * TP * 32, row0, nt, scb, 2048, wave);
        __syncthreads();
        const int nj = nt >> 1;
#define SEL2(N_) { b1_select<N_>(scb + (2 * wave) * 2048, nj, mo); b1_select<N_>(scb + (2 * wave + 1) * 2048, nj, mo + 64); }
        switch ((nj + 3) >> 2) {
          case 2: SEL2(8) break;
          case 3: SEL2(12) break;
          case 4: SEL2(16) break;
          case 5: SEL2(20) break;
          case 6: SEL2(24) break;
          case 7: SEL2(28) break;
          default: SEL2(32) break;
        }
#undef SEL2
      }
    } else if (mi < NPG) {
      for (int k = 0; k < 8; ++k) pooled_item(p, layer, mi * 8 + k);
    } else if (mi < NPG + NCK) {
      for (int k = 0; k < 8; ++k) conv_cache_k(p, layer, (mi - NPG) * 8 + k);
    } else if (mi < NPG + NCK + NCV) {
      for (int k = 0; k < 8; ++k) conv_cache_v(p, layer, (mi - NPG - NCK) * 8 + k);
    } else {
      for (int k = 0; k < 8; ++k) weight_item(p, 1, (mi - NPG - NCK - NCV) * 8 + k, (float*)lds);
    }
  }
}

DI void attn_item(const P& p, bool isS, int b, int h, int qblk, char* lds) {
  const int tid = tidx(), lane = tid & 63, wave = __builtin_amdgcn_readfirstlane(tid >> 6);
  const int r = lane & 31, hl = lane >> 5;
  int qbase, nkt, L, MW; const bf16_t *Kb, *Vb; const unsigned* Mb;
  if (isS) {
    qbase = NTP + b * 64; nkt = 65; L = LS; MW = 192;
    Kb = (const bf16_t*)(p.ws + W_KS) + (size_t)b * LS * 512 + h * 64;
    Vb = (const bf16_t*)(p.ws + W_VTS) + (size_t)(b * 8 + h) * 64 * LS;
    Mb = (const unsigned*)(p.ws + W_MASKS) + (size_t)(b * 64) * 192;
  } else {
    qbase = b * TP + qblk * 128; nkt = 2 * qblk + 2; L = TP; MW = 64;
    Kb = (const bf16_t*)(p.ws + W_KP) + (size_t)b * TP * 512 + h * 64;
    Vb = (const bf16_t*)(p.ws + W_VTP) + (size_t)(b * 8 + h) * 64 * TP;
    Mb = (const unsigned*)(p.ws + W_MASKP) + (size_t)qbase * 64;
  }
  const bool wvalid = !isS || wave < 2;
  const int ql = wvalid ? wave * 32 + r : r;
  const int qrow = qbase + ql;
  const bf16_t* qp = (const bf16_t*)(p.ws + W_Q) + (size_t)qrow * 512 + h * 64 + 8 * hl;
  bf16x8 qf[4];
#pragma unroll
  for (int s = 0; s < 4; ++s) qf[s] = *(const bf16x8*)(qp + 16 * s);
  const unsigned* mrow = Mb + (size_t)ql * MW;
  const int lr = tid >> 3, lc = tid & 7;
  const int swk = (lc ^ ((lr >> 1) & 7)) << 4;
  u32x4 rk0[2], rv0[2], rk1[2], rv1[2];
  u32x2 mwA, mwB, mwC;
#define AGL(rk, rv, mwx, kt_)                                                                  \
  _Pragma("unroll") for (int i = 0; i < 2; ++i) {                                              \
    rk[i] = *(const u32x4*)(Kb + (size_t)((kt_) * 64 + lr + 32 * i) * 512 + lc * 8);           \
    rv[i] = *(const u32x4*)(Vb + (size_t)(lr + 32 * i) * L + (kt_) * 64 + lc * 8);             \
  }                                                                                            \
  mwx = *(const u32x2*)(mrow + 2 * (kt_));
#define ALS(rk, rv, st_)                                                                       \
  _Pragma("unroll") for (int i = 0; i < 2; ++i) {                                              \
    const int row = lr + 32 * i;                                                               \
    *(u32x4*)(lds + (st_) * 16384 + row * 128 + swk) = rk[i];                                  \
    *(u32x4*)(lds + (st_) * 16384 + 8192 + row * 128 + swk) = rv[i];                           \
  }
  f32x16 ot[2];
#pragma unroll
  for (int i = 0; i < 16; ++i) { ot[0][i] = 0.f; ot[1][i] = 0.f; }
  float mrun = -1e30f, lsum = 0.f;
  const int fxk = (r >> 1) & 7;
  auto tile_compute = [&](const char* base, const u32x2 mw) {
    f32x16 st[2];
    bf16x8 kf[2][4];
#pragma unroll
    for (int kb = 0; kb < 2; ++kb)
#pragma unroll
      for (int s = 0; s < 4; ++s) kf[kb][s] = *(const bf16x8*)(base + (kb * 32 + r) * 128 + (((2 * s + hl) ^ fxk) << 4));
    __builtin_amdgcn_s_setprio(1);
#pragma unroll
    for (int kb = 0; kb < 2; ++kb) {
#pragma unroll
      for (int i = 0; i < 16; ++i) st[kb][i] = 0.f;
#pragma unroll
      for (int s = 0; s < 4; ++s) st[kb] = MFMA32(kf[kb][s], qf[s], st[kb]);
    }
    __builtin_amdgcn_s_setprio(0);
    float tmax = -INFINITY;
#pragma unroll
    for (int kb = 0; kb < 2; ++kb) {
      const unsigned wk = mw[kb] >> (4 * hl);
#pragma unroll
      for (int i = 0; i < 16; ++i) {
        const int bit = (i & 3) + 8 * (i >> 2);
        const float v = ((wk >> bit) & 1u) ? st[kb][i] : -INFINITY;
        st[kb][i] = v;
        tmax = fmaxf(tmax, v);
      }
    }
    if (__any(tmax - mrun > 32.f)) {
      const float mnew = fmaxf(mrun, fmaxf(tmax, __shfl_xor(tmax, 32)));
      const float alpha = __builtin_amdgcn_exp2f(mrun - mnew);
      mrun = mnew;
      lsum *= alpha;
#pragma unroll
      for (int i = 0; i < 16; ++i) { ot[0][i] *= alpha; ot[1][i] *= alpha; }
    }
    f32x2 ps2 = {0.f, 0.f};
#pragma unroll
    for (int kb = 0; kb < 2; ++kb)
#pragma unroll
      for (int i = 0; i < 16; i += 2) {
        const float p0 = __builtin_amdgcn_exp2f(st[kb][i] - mrun), p1 = __builtin_amdgcn_exp2f(st[kb][i + 1] - mrun);
        st[kb][i] = p0; st[kb][i + 1] = p1;
        ps2 += f32x2{p0, p1};
      }
    lsum += ps2.x + ps2.y;
#pragma unroll
    for (int kb = 0; kb < 2; ++kb)
#pragma unroll
      for (int s2 = 0; s2 < 2; ++s2) {
        const u32x4 pp = u32x4{pk2(st[kb][8 * s2 + 0], st[kb][8 * s2 + 1]), pk2(st[kb][8 * s2 + 2], st[kb][8 * s2 + 3]),
                               pk2(st[kb][8 * s2 + 4], st[kb][8 * s2 + 5]), pk2(st[kb][8 * s2 + 6], st[kb][8 * s2 + 7])};
        const bf16x8 pf = __builtin_bit_cast(bf16x8, pp);
        const int c1 = 2 * (2 * kb + s2) + hl;
#pragma unroll
        for (int db = 0; db < 2; ++db) {
          const bf16x8 vf = *(const bf16x8*)(base + 8192 + (db * 32 + r) * 128 + ((c1 ^ fxk) << 4));
          ot[db] = MFMA32(vf, pf, ot[db]);
        }
      }
  };
  __syncthreads();
  AGL(rk0, rv0, mwA, 0)
  if (nkt > 1) { AGL(rk1, rv1, mwB, 1) }
  ALS(rk0, rv0, 0)
  __syncthreads();
  for (int kt = 0; kt < nkt; kt += 2) {
    if (kt + 2 < nkt) { AGL(rk0, rv0, mwC, kt + 2) }
    tile_compute(lds, mwA);
    if (kt + 1 < nkt) { ALS(rk1, rv1, 1) }
    __syncthreads();
    if (kt + 1 >= nkt) break;
    const u32x2 mwB_ = mwB;
    if (kt + 3 < nkt) { AGL(rk1, rv1, mwB, kt + 3) }
    tile_compute(lds + 16384, mwB_);
    mwA = mwC;
    if (kt + 2 < nkt) { ALS(rk0, rv0, 0) }
    __syncthreads();
  }
#undef AGL
#undef ALS
  const float ltot = lsum + __shfl_xor(lsum, 32);
  const float inv = 1.f / ltot;
  if (wvalid) {
    bf16_t* za = (bf16_t*)(p.ws + W_ZA) + (size_t)qrow * 512 + h * 64;
#pragma unroll
    for (int db = 0; db < 2; ++db)
#pragma unroll
      for (int g4 = 0; g4 < 4; ++g4) {
        const int d = db * 32 + 8 * g4 + 4 * hl;
        const u32x2 z = *(const u32x2*)(za + d);
        const float z0 = __uint_as_float(z.x << 16), z1 = __uint_as_float(z.x & 0xffff0000u), z2 = __uint_as_float(z.y << 16), z3 = __uint_as_float(z.y & 0xffff0000u);
        *(u32x2*)(za + d) = u32x2{pk2(ot[db][4 * g4] * inv * z0, ot[db][4 * g4 + 1] * inv * z1), pk2(ot[db][4 * g4 + 2] * inv * z2, ot[db][4 * g4 + 3] * inv * z3)};
      }
  }
}

DI void mix_tile(const P& p, int layer, int tile, char* lds) {
  const int lane = tidx() & 63, wave = __builtin_amdgcn_readfirstlane(tidx() >> 6);
  const int mt = tile >> 2, g = tile & 3;
  const int row0 = mt * 128;
  f32x4 acc[4][4];
  zero_acc(acc);
  bf16_t* PA = (bf16_t*)(p.ws + W_POOLED);
  gemm_tile(PA + (size_t)row0 * 512 + g * 128, 512, (const bf16_t*)(p.ws + W_WMIX) + (size_t)(layer * 4 + g) * 128 * 128, 128, 128, 128, acc, lds);
  const int wm = wave >> 1, wn = wave & 1, fr = lane & 15, fq = lane >> 4;
  float* stg = (float*)lds;
  stage_acc(acc, stg, wm, wn, fr, fq);
  __syncthreads();
  const int col = g * 128 + wn * 64 + fr * 4;
  const f32x4 sc = *(const f32x4*)(p.pool_scale + layer * 512 + col);
  u32x2 zr[16];
#pragma unroll
  for (int ps = 0; ps < 16; ++ps) zr[ps] = *(const u32x2*)((const bf16_t*)(p.ws + W_ZP) + (size_t)(row0 + ps * 8 + wm * 4 + fq) * 512 + col);
#pragma unroll
  for (int ps = 0; ps < 16; ++ps) {
    const int lr = ps * 8 + wm * 4 + fq;
    const f32x4 v = *(const f32x4*)(stg + lr * EPS + wn * 64 + fr * 4) * sc;
    const u32x2 z = zr[ps];
    *(u32x2*)(PA + (size_t)(row0 + lr) * 512 + col) = u32x2{pk2(v.x * __uint_as_float(z.x << 16), v.y * __uint_as_float(z.x & 0xffff0000u)), pk2(v.z * __uint_as_float(z.y << 16), v.w * __uint_as_float(z.y & 0xffff0000u))};
  }
  __syncthreads();
}

PHASE_FN void phaseC(const P& p, int layer, char* lds) {
  constexpr int NQ = 8 + 256 + MTILES * 4 / 8;
  int* slot = (int*)(lds + RR_OFF + 496);
  const int x0 = blockIdx.x & 7;
  for (int k = 0; k < 8; ++k) {
    const int x = (x0 + k) & 7;
    unsigned* ctr = (unsigned*)(p.ws + W_BAR) + 3520 + 128 + layer * 512 + x * 64;
    for (;;) {
      const int li = next_ticket(ctr, slot);
      if (li >= NQ) break;
      if (li < 8) attn_item(p, true, li, x, 0, lds);
      else if (li < 264) { const int j = (li - 8) & 127, rr_ = j & 31; attn_item(p, false, (j >> 5) * 4 + (rr_ & 3), x, ((li - 8) < 128 ? 15 : 7) - (rr_ >> 2), lds); }
      else mix_tile(p, layer, (li - 264) * 8 + x, lds);
    }
  }
}

DI void phaseD_tile(const P& p, int layer, int mt, int nt, char* lds) {
  const int lane = tidx() & 63, wave = __builtin_amdgcn_readfirstlane(tidx() >> 6);
  const int row0 = mt * 128, col0 = nt * 128;
  const int wm = wave >> 1, wn = wave & 1, fr = lane & 15, fq = lane >> 4;
  f32x4 acc[4][4];
  zero_acc(acc);
  const size_t goff = ((size_t)((mt * 2 + wm) * 16 + nt * 2 + wn) * 64 + lane) * 16;
  const unsigned* GP = (const unsigned*)(p.ws + W_GP) + goff;
  const unsigned* GA = (const unsigned*)(p.ws + W_GA) + goff;
  u32x4 gpv[4], gav[4];
#pragma unroll
  for (int mi = 0; mi < 4; ++mi) { gpv[mi] = *(const u32x4*)(GP + mi * 4); gav[mi] = *(const u32x4*)(GA + mi * 4); }
  gemm_tile((const bf16_t*)(p.ws + W_POOLED) + (size_t)row0 * 512, 512, (const bf16_t*)(p.ws + W_WPO) + ((size_t)layer * 1024 + col0) * 512, 512, 128, 512, acc, lds);
  gemm_prefetch0((const bf16_t*)(p.ws + W_ZA) + (size_t)row0 * 512, 512, (const bf16_t*)(p.ws + W_WAO) + ((size_t)layer * 1024 + col0) * 512, 512, 128, lds);
#pragma unroll
  for (int mi = 0; mi < 4; ++mi)
#pragma unroll
    for (int ni = 0; ni < 4; ++ni)
#pragma unroll
      for (int j = 0; j < 4; ++j) acc[mi][ni][j] *= (float)((gpv[mi][ni] >> (8 * j)) & 255u) / fmaxf((float)((gav[mi][ni] >> (8 * j)) & 255u), 1.f);
  gemm_tile((const bf16_t*)(p.ws + W_ZA) + (size_t)row0 * 512, 512, (const bf16_t*)(p.ws + W_WAO) + ((size_t)layer * 1024 + col0) * 512, 512, 128, 512, acc, lds, true);
#pragma unroll
  for (int mi = 0; mi < 4; ++mi)
#pragma unroll
    for (int ni = 0; ni < 4; ++ni)
#pragma unroll
      for (int j = 0; j < 4; ++j) acc[mi][ni][j] *= fmaxf((float)((gav[mi][ni] >> (8 * j)) & 255u), 1.f) * (1.f / 255.f);
  float* tile = (float*)lds;
  stage_acc(acc, tile, wm, wn, fr, fq);
  __syncthreads();
  bf16_t* MG = (bf16_t*)(p.ws + W_MERGED);
#pragma unroll 1
  for (int ps = 0; ps < 16; ++ps) {
    const int lr = ps * 8 + wm * 4 + fq;
    const f32x4 v = *(const f32x4*)(tile + lr * EPS + wn * 64 + fr * 4);
    *(u32x2*)(MG + (size_t)(row0 + lr) * LDX + col0 + wn * 64 + fr * 4) = u32x2{pk2(v.x, v.y), pk2(v.z, v.w)};
  }
  __syncthreads();
}

PHASE_FN void phaseD(const P& p, int layer, char* lds) {
  { XcdWalk w; w.init(MTILES, 8); int mt, nt; while (w.next(mt, nt)) phaseD_tile(p, layer, mt, nt, lds); }
}

DI void phaseE_tile(const P& p, int layer, int mt, int nt, char* lds) {
  const int lane = tidx() & 63, wave = __builtin_amdgcn_readfirstlane(tidx() >> 6);
  const int row0 = mt * 128, col0 = nt * 128;
  const int wm = wave >> 1, wn = wave & 1, fr = lane & 15, fq = lane >> 4;
  f32x4 acc[4][4];
  zero_acc(acc);
  float* XF = p.out;
  const int col = col0 + wn * 64 + fr * 4;
  f32x4 xr[16];
#pragma unroll
  for (int ps = 0; ps < 16; ++ps) {
    const int row = row0 + ps * 8 + wm * 4 + fq;
    const float* xin = (layer == 0) ? ((row < NTP) ? p.x_p + (size_t)row * DM : p.x_s + (size_t)(row - NTP) * DM) : XF + (size_t)row * DM;
    xr[ps] = __builtin_nontemporal_load((const f32x4*)(xin + col));
  }
  gemm_tile((const bf16_t*)(p.ws + W_MERGED) + (size_t)row0 * LDX, LDX, (const bf16_t*)(p.ws + W_WO) + ((size_t)layer * 1024 + col0) * LDX, LDX, 128, 1024, acc, lds);
  float* tile = (float*)lds;
  stage_acc(acc, tile, wm, wn, fr, fq);
  __syncthreads();
  bf16_t* XB = (bf16_t*)(p.ws + W_XB);
  float* SS = (float*)(p.ws + W_SS);
#pragma unroll
  for (int ps = 0; ps < 16; ++ps) {
    const int lr = ps * 8 + wm * 4 + fq, row = row0 + lr;
    const f32x4 v = xr[ps] + *(const f32x4*)(tile + lr * EPS + wn * 64 + fr * 4);
    *(f32x4*)(XF + (size_t)row * DM + col) = v;
    if (layer == 0) *(u32x2*)(XB + (size_t)row * DM + col) = u32x2{pk2(v.x, v.y), pk2(v.z, v.w)};
    const float ss = row16_sum(v.x * v.x + v.y * v.y + v.z * v.z + v.w * v.w);
    if (fr == 0) SS[(size_t)row * 16 + nt * 2 + wn] = ss;
  }
  __syncthreads();
}

PHASE_FN void phaseF(const P& p) {
  const int lane = tidx() & 63, wave = __builtin_amdgcn_readfirstlane(tidx() >> 6);
  f32x4 g[4];
#pragma unroll
  for (int j = 0; j < 4; ++j) g[j] = *(const f32x4*)(p.final_g + j * 256 + lane * 4);
  for (int it = blockIdx.x; it < NTOK / 16; it += gridDim.x) {
    const int rowb = it * 16 + wave * 4;
    f32x4 sv[4][4], xv[4][4];
#pragma unroll
    for (int q = 0; q < 4; ++q) {
      const float* sp = (const float*)(p.ws + W_SS) + (size_t)(rowb + q) * 16;
      const float* x = p.out + (size_t)(rowb + q) * DM;
#pragma unroll
      for (int j = 0; j < 4; ++j) { sv[q][j] = *(const f32x4*)(sp + 4 * j); xv[q][j] = *(const f32x4*)(x + j * 256 + lane * 4); }
    }
#pragma unroll
    for (int q = 0; q < 4; ++q) {
      float ss = 0.f;
#pragma unroll
      for (int j = 0; j < 4; ++j) ss += (sv[q][j].x + sv[q][j].y) + (sv[q][j].z + sv[q][j].w);
      const float r = rsqrtf(ss * (1.f / 1024.f) + 1e-6f);
      float* x = p.out + (size_t)(rowb + q) * DM;
#pragma unroll
      for (int j = 0; j < 4; ++j) {
        f32x4 v = xv[q][j];
        v.x *= r * g[j].x; v.y *= r * g[j].y; v.z *= r * g[j].z; v.w *= r * g[j].w;
        __builtin_nontemporal_store(v, (f32x4*)(x + j * 256 + lane * 4));
      }
    }
  }
}

PHASE_FN void phaseA(const P& p, int layer, char* lds) {
  constexpr int MOVE = 21;
  XcdWalk w; w.init(MTILES, NTN);
  const bool split = w.x >= 0 && (MTILES & 7) == 4;
  if (split && w.x < 4) w.total -= MOVE;
  int mt, nt;
  while (w.next(mt, nt)) phaseA_tile(p, layer, mt, nt, lds);
  if (split && w.x >= 4) {
    XcdWalk w2; w2.init(MTILES, NTN);
    w2.x = w.x - 4; w2.mx = (MTILES - w2.x + 7) >> 3; w2.total = w2.mx * NTN; w2.L = w2.total - MOVE + (blockIdx.x >> 3);
    while (w2.next(mt, nt)) phaseA_tile(p, layer, mt, nt, lds);
  }
}
PHASE_FN void phaseE(const P& p, int layer, char* lds) { XcdWalk w; w.init(MTILES, 8); int mt, nt; while (w.next(mt, nt)) phaseE_tile(p, layer, mt, nt, lds); }

DI void run_phase(const P& p, int ph, char* lds) {
  if (ph == 0) { phase0(p, lds); return; }
  if (ph == 11) { phaseF(p); return; }
  const int layer = (ph - 1) / 5, sub = (ph - 1) % 5;
#ifndef SKIP_A
  if (sub == 0) phaseA(p, layer, lds);
#endif
#ifndef SKIP_B
  if (sub == 1) phaseB(p, layer, lds);
#endif
#ifndef SKIP_C
  if (sub == 2) phaseC(p, layer, lds);
#endif
#ifndef SKIP_D
  if (sub == 3) phaseD(p, layer, lds);
#endif
#ifndef SKIP_E
  if (sub == 4) phaseE(p, layer, lds);
#endif
}


#define XB_TMO      128
#define XB_XCNT(j)  (256  + 64 * (j))
#define XB_XSUB(j)  (1280 + 64 * (j))
#define XB_XGEN(j)  (2304 + 64 * (j))
#define XB_TOP      3328
#define XB_TOPGEN   3392
#define XCD_BAR_WORDS 3456
#define XB_SPIN_CAP (1u << 22)
#define LAS __attribute__((address_space(3)))
DI unsigned xb_ld(unsigned* p) { return __hip_atomic_load(p, __ATOMIC_RELAXED, __HIP_MEMORY_SCOPE_AGENT); }
DI unsigned xb_add(unsigned* p, unsigned v) { return __hip_atomic_fetch_add(p, v, __ATOMIC_RELAXED, __HIP_MEMORY_SCOPE_AGENT); }
DI unsigned xb_xcc_id() { return (unsigned)__builtin_amdgcn_s_getreg((3 << 11) | 20) & 0xFu; }
#define XB_SPIN(cond, bar) do { unsigned _sp = 0; while (cond) { __builtin_amdgcn_s_sleep(1); \
    if ((++_sp & 255u) == 0u) { if (xb_ld(&(bar)[XB_TMO])) break; if (_sp > XB_SPIN_CAP) { atomicAdd(&(bar)[XB_TMO], 1u); break; } } } } while (0)
struct XcdBarrier { unsigned* bar; unsigned x; volatile LAS unsigned* st; };
DI XcdBarrier xcd_barrier_post(unsigned* bar, volatile LAS unsigned* st) {
  XcdBarrier b; b.bar = bar; b.x = xb_xcc_id(); b.st = st;
  if (__builtin_amdgcn_workitem_id_x() == 0) (void)xb_add(&bar[XB_XCNT(b.x)], 1u);
  return b;
}
DI void xcd_barrier_complete(unsigned* bar, unsigned x, unsigned& nloc, unsigned& nx) {
  const unsigned G = gridDim.x;
  unsigned sum, cnt, mine, sp = 0u;
  for (;;) {
    sum = 0u; cnt = 0u; mine = 0u;
#pragma unroll
    for (unsigned j = 0; j < 16; ++j) { const unsigned c = xb_ld(&bar[XB_XCNT(j)]); sum += c; cnt += (c > 0u) ? 1u : 0u; mine = (j == x) ? c : mine; }
    if (sum == G) break;
    __builtin_amdgcn_s_sleep(1);
    if ((++sp & 255u) == 0u) { if (xb_ld(&bar[XB_TMO])) break; if (sp > XB_SPIN_CAP) { atomicAdd(&bar[XB_TMO], 1u); break; } }
  }
  nloc = mine > 0u ? mine : 1u; nx = cnt > 0u ? cnt : 1u;
}
DI void xcd_barrier(const XcdBarrier& b) {
  asm volatile("s_waitcnt vmcnt(0)" ::: "memory");
  __syncthreads();
  if (__builtin_amdgcn_workitem_id_x() == 0) {
    unsigned* bar = b.bar;
    __builtin_amdgcn_s_waitcnt(0);
    unsigned nloc = b.st[0], nx = b.st[1];
    if (nloc == 0u) { xcd_barrier_complete(bar, b.x, nloc, nx); b.st[0] = nloc; b.st[1] = nx; }
    const unsigned old = xb_add(&bar[XB_XSUB(b.x)], 1u);
    const unsigned gen = old / nloc;
    if (old + 1u == (gen + 1u) * nloc) {
      __builtin_amdgcn_fence(__ATOMIC_RELEASE, "agent");
      asm volatile("s_waitcnt vmcnt(0)" ::: "memory");
      const unsigned og = xb_add(&bar[XB_TOP], 1u);
      const unsigned tg = og / nx;
      if (og + 1u == (tg + 1u) * nx) xb_add(&bar[XB_TOPGEN], 1u);
      else XB_SPIN(xb_ld(&bar[XB_TOPGEN]) == tg, bar);
      __builtin_amdgcn_fence(__ATOMIC_ACQUIRE, "agent");
      xb_add(&bar[XB_XGEN(b.x)], 1u);
      asm volatile("s_waitcnt vmcnt(0)" ::: "memory");
    } else {
      XB_SPIN(xb_ld(&bar[XB_XGEN(b.x)]) == gen, bar);
      __builtin_amdgcn_fence(__ATOMIC_ACQUIRE, "agent");
      asm volatile("s_waitcnt vmcnt(0)" ::: "memory");
    }
  }
  __syncthreads();
}

__global__ void __launch_bounds__(256, 2) mega(P p, int ph_lo, int ph_hi, int coop) {
  __shared__ __attribute__((aligned(16))) char lds[LDS_BYTES];
  __shared__ uint4 xb_words;
  XcdBarrier xb;
  if (coop) {
    if (__builtin_amdgcn_workitem_id_x() == 0) xb_words = make_uint4(0u, 0u, 0u, 0u);
    __syncthreads();
    xb = xcd_barrier_post((unsigned*)(p.ws + W_BAR), (volatile LAS unsigned*)&xb_words);
  }
  for (int ph = ph_lo; ph < ph_hi; ++ph) {
    run_phase(p, ph, lds);
    if (coop && ph + 1 < ph_hi) {
      if (coop == 2) cg::this_grid().sync();
      xcd_barrier(xb);
    }
  }
}

extern "C" void kernel_launch(void* const* d_in, const int* in_sizes, int n_in, void* d_out, int out_size, void* d_ws, size_t ws_size, hipStream_t stream) {
  if (n_in != 14 || (size_t)out_size != O_END || ws_size < W_END) { fprintf(stderr, "kernel_launch: unexpected shapes (n_in %d out %d ws %zu need %zu)\n", n_in, out_size, ws_size, (size_t)W_END); return; }
  P p{};
  p.x_p = (const float*)d_in[0]; p.x_s = (const float*)d_in[1]; p.cache_k = (const float*)d_in[2]; p.cache_v = (const float*)d_in[3];
  p.cache_ki = (const float*)d_in[4]; p.state_pool = (const float*)d_in[5]; p.norm_g = (const float*)d_in[6]; p.w_in = (const float*)d_in[7];
  p.w_mix = (const float*)d_in[8]; p.pool_scale = (const float*)d_in[9]; p.w_po = (const float*)d_in[10]; p.w_ao = (const float*)d_in[11];
  p.w_o = (const float*)d_in[12]; p.final_g = (const float*)d_in[13];
  p.out = (float*)d_out; p.ws = (char*)d_ws;
  static int grid = 0;
  if (!grid) {
    int dev = 0, cus = 0, per_cu = 0;
    hipGetDevice(&dev);
    hipDeviceGetAttribute(&cus, hipDeviceAttributeMultiprocessorCount, dev);
    hipOccupancyMaxActiveBlocksPerMultiprocessor(&per_cu, mega, 256, 0);
    if (per_cu > 2) per_cu = 2;
    if (per_cu < 1) per_cu = 1;
    grid = cus * per_cu;
  }
#if MULTI_LAUNCH
#ifdef PROBE_SEQ
  const int seq[] = {PROBE_SEQ};
  for (int ph : seq) hipLaunchKernelGGL(mega, dim3(grid), dim3(256), 0, stream, p, ph, ph + 1, 0);
#else
  for (int ph = 0; ph < 12; ++ph) hipLaunchKernelGGL(mega, dim3(grid), dim3(256), 0, stream, p, ph, ph + 1, 0);
#endif
#else
  int lo = 0, hi = 12, coop = 1;
  (void)hipMemsetAsync((char*)d_ws + W_BAR, 0, 32768, stream);
  void* args[] = {&p, &lo, &hi, &coop};
  hipError_t e = hipLaunchCooperativeKernel((void*)mega, dim3(grid), dim3(256), args, 0, stream);
  if (e != hipSuccess) fprintf(stderr, "cooperative launch failed: %s (grid %d)\n", hipGetErrorString(e), grid);
#endif
}
```

```cpp
#include <hip/hip_runtime.h>
#include <hip/hip_cooperative_groups.h>
#include <stdint.h>
#include <cstdio>
namespace cg = cooperative_groups;

#ifndef MULTI_LAUNCH
#define MULTI_LAUNCH 0
#endif

typedef unsigned short bf16_t;
typedef short bf16x8 __attribute__((ext_vector_type(8)));
typedef short s16x4 __attribute__((ext_vector_type(4)));
typedef float f32x4 __attribute__((ext_vector_type(4)));
typedef float f32x2 __attribute__((ext_vector_type(2)));
typedef float f32x16 __attribute__((ext_vector_type(16)));
typedef unsigned u32x4 __attribute__((ext_vector_type(4)));
typedef unsigned u32x2 __attribute__((ext_vector_type(2)));
#define DI __device__ __forceinline__
#ifndef PHASE_FN
#define PHASE_FN __device__ __forceinline__
#endif

constexpr int DM = 1024, NTP = 32768, NTS = 512, NTOK = NTP + NTS;
constexpr int TP = 2048, TS = 64, PAST = 4096, LS = PAST + TS;
constexpr int NCOL = 5416, NP = 5440, NSEG = 85, NTN = 43;
constexpr int MTILES = NTOK / 128;
constexpr int LDX = 1024 + 64;
constexpr float QSCALE = 0.125f * 1.4426950408889634f;

constexpr size_t O_YP = 0;
constexpr size_t O_YS = O_YP + (size_t)NTP * DM;
constexpr size_t O_KP = O_YS + (size_t)NTS * DM;
constexpr size_t O_VP = O_KP + 2ull * 16 * TP * 512;
constexpr size_t O_KIP = O_VP + 2ull * 16 * TP * 512;
constexpr size_t O_PP = O_KIP + 2ull * 16 * TP * 32;
constexpr size_t O_KS = O_PP + 2ull * 16 * 15 * 512;
constexpr size_t O_VS = O_KS + 2ull * 8 * TS * 512;
constexpr size_t O_KIS = O_VS + 2ull * 8 * TS * 512;
constexpr size_t O_PS = O_KIS + 2ull * 8 * TS * 32;
constexpr size_t O_END = O_PS + 2ull * 8 * 15 * 512;

constexpr size_t al(size_t x) { return (x + 255) & ~size_t(255); }
constexpr size_t W_WIN = 0;
constexpr size_t W_WMIX = W_WIN + al(2ull * NP * 1024 * 2);
constexpr size_t W_WPO = W_WMIX + al(2ull * 4 * 128 * 128 * 2);
constexpr size_t W_WAO = W_WPO + al(2ull * 1024 * 512 * 2);
constexpr size_t W_WO = W_WAO + al(2ull * 1024 * 512 * 2);
constexpr size_t W_R64 = W_WO + al(2ull * 1024 * LDX * 2);
constexpr size_t W_R32 = W_R64 + al((size_t)LS * 32 * 8);
constexpr size_t W_XB = W_R32 + al((size_t)LS * 16 * 8);
constexpr size_t W_POOLED = W_XB;
constexpr size_t W_MASKP = W_XB + al((size_t)NTOK * 512 * 2);
constexpr size_t W_MASKS = W_MASKP + al((size_t)NTP * 64 * 4);
constexpr size_t W_SS = W_XB + al((size_t)NTOK * 1024 * 2);
static_assert(W_MASKS + (size_t)NTS * 192 * 4 <= W_SS, "mask alias overflow");
constexpr size_t W_U = W_SS + al((size_t)NTOK * 16 * 4);
constexpr size_t W_Q = W_U + (size_t)NTOK * 512 * 2;
constexpr size_t W_MERGED = W_U;
static_assert((size_t)NTOK * LDX * 2 <= 3 * (size_t)NTOK * 512 * 2, "MERGED alias overflow");
constexpr size_t W_ZP = W_Q + al((size_t)NTOK * 512 * 2);
constexpr size_t W_KP = W_ZP + al((size_t)NTOK * 512 * 2);
constexpr size_t W_VTP = W_KP + al(16ull * TP * 512 * 2);
constexpr size_t W_KS = W_VTP + al(16ull * TP * 512 * 2);
constexpr size_t W_VTS = W_KS + al(8ull * LS * 512 * 2);
constexpr size_t W_QI = W_VTS + al(8ull * LS * 512 * 2);
constexpr size_t W_KIP = W_QI + al((size_t)NTOK * 256 * 2);
constexpr size_t W_KIS = W_KIP + al(16ull * TP * 32 * 2);
constexpr size_t W_WI = W_KIS + al(2ull * 8 * LS * 32 * 2);
constexpr size_t W_ZA = W_WI + al((size_t)NTOK * 8 * 4);
constexpr size_t W_GP = W_ZA + al((size_t)NTOK * 512 * 2);
constexpr size_t W_GA = W_GP + al((size_t)NTOK * 1024);
constexpr size_t W_BAR = W_GA + al((size_t)NTOK * 1024);
constexpr size_t W_END = W_BAR + 32768;

struct P {
  const float *x_p, *x_s, *cache_k, *cache_v, *cache_ki, *state_pool, *norm_g, *w_in, *w_mix, *pool_scale, *w_po, *w_ao, *w_o, *final_g;
  float* out;
  char* ws;
};

constexpr int EPS = 132;
constexpr int RR_OFF = 128 * EPS * 4;
constexpr int LDS_BYTES = RR_OFF + 512;

DI int tidx() { int t = __builtin_amdgcn_workitem_id_x(); asm volatile("" : "+v"(t)); return t; }
DI float bf2f(bf16_t b) { return __uint_as_float(((unsigned)b) << 16); }
DI unsigned pk2(float lo, float hi) { unsigned r; asm("v_cvt_pk_bf16_f32 %0, %1, %2" : "=v"(r) : "v"(lo), "v"(hi)); return r; }
DI bf16_t f2bf(float x) { return (bf16_t)(pk2(x, 0.f) & 0xffffu); }
DI float sigmoidf_(float v) { return 1.f / (1.f + __expf(-v)); }
DI float siluf_(float v) { return v / (1.f + __expf(-v)); }
DI float wave_sum(float v) {
#pragma unroll
  for (int o = 1; o < 64; o <<= 1) v += __shfl_xor(v, o);
  return v;
}
#define MFMA16(a, b, c) __builtin_amdgcn_mfma_f32_16x16x32_bf16((a), (b), (c), 0, 0, 0)
#define MFMA32(a, b, c) __builtin_amdgcn_mfma_f32_32x32x16_bf16((a), (b), (c), 0, 0, 0)

DI void gemm_tile(const bf16_t* __restrict__ A, int lda, const bf16_t* __restrict__ Bt, int ldb, int bvalid, int K, f32x4 (&acc)[4][4], char* lds, bool preloaded = false) {
  const int tid = tidx(), lane = tid & 63, wave = __builtin_amdgcn_readfirstlane(tid >> 6);
  const int wm = wave >> 1, wn = wave & 1;
  const int lr = tid >> 3, lc = tid & 7;
  const int fr = lane & 15, fq = lane >> 4;
  const int fx = (fr >> 1) & 7;
  const bf16_t* ap = A + (size_t)lr * lda + ((lc ^ ((lr >> 1) & 7)) << 3);
  const bf16_t* bp = Bt + ((lc ^ ((lr >> 1) & 7)) << 3);
  typedef __attribute__((address_space(1))) const unsigned gptr_t;
  typedef __attribute__((address_space(3))) unsigned lptr_t;
  const unsigned lbase = (unsigned)(size_t)lds + (unsigned)tid * 16u;
#define GLDS(st, k0)                                                                                                             \
  _Pragma("unroll") for (int i = 0; i < 4; ++i) {                                                                                \
    __builtin_amdgcn_global_load_lds((gptr_t*)(ap + (size_t)(32 * i) * lda + (k0)), (lptr_t*)(lbase + (st) * 32768 + i * 4096), 16, 0, 0);          \
    __builtin_amdgcn_global_load_lds((gptr_t*)(bp + (size_t)((lr + 32 * i) & (bvalid - 1)) * ldb + (k0)), (lptr_t*)(lbase + (st) * 32768 + 16384 + i * 4096), 16, 0, 0); \
  }
  auto compute = [&](int st) {
    const char* base = lds + st * 32768;
    bf16x8 af[2][4], bfr[2][4];
#pragma unroll
    for (int s = 0; s < 2; ++s) {
      const int ch = ((4 * s + fq) ^ fx) << 4;
#pragma unroll
      for (int mi = 0; mi < 4; ++mi) af[s][mi] = *(const bf16x8*)(base + (wm * 64 + mi * 16 + fr) * 128 + ch);
#pragma unroll
      for (int ni = 0; ni < 4; ++ni) bfr[s][ni] = *(const bf16x8*)(base + 16384 + (wn * 64 + ni * 16 + fr) * 128 + ch);
    }
    __builtin_amdgcn_s_setprio(1);
#pragma unroll
    for (int s = 0; s < 2; ++s)
#pragma unroll
      for (int mi = 0; mi < 4; ++mi)
#pragma unroll
        for (int ni = 0; ni < 4; ++ni) acc[mi][ni] = MFMA16(af[s][mi], bfr[s][ni], acc[mi][ni]);
    __builtin_amdgcn_s_setprio(0);
  };
  const int nk = K >> 6;
  if (!preloaded) { GLDS(0, 0) }
  __syncthreads();
  for (int kt = 0; kt < nk; ++kt) {
    if (kt + 1 < nk) { GLDS((kt + 1) & 1, (kt + 1) << 6) }
    compute(kt & 1);
    __syncthreads();
  }
#undef GLDS
}

DI void gemm_prefetch0(const bf16_t* __restrict__ A, int lda, const bf16_t* __restrict__ Bt, int ldb, int bvalid, char* lds) {
  const int tid = tidx();
  const int lr = tid >> 3, lc = tid & 7;
  const bf16_t* ap = A + (size_t)lr * lda + ((lc ^ ((lr >> 1) & 7)) << 3);
  const bf16_t* bp = Bt + ((lc ^ ((lr >> 1) & 7)) << 3);
  typedef __attribute__((address_space(1))) const unsigned gptr_t;
  typedef __attribute__((address_space(3))) unsigned lptr_t;
  const unsigned lbase = (unsigned)(size_t)lds + (unsigned)tid * 16u;
#pragma unroll
  for (int i = 0; i < 4; ++i) {
    __builtin_amdgcn_global_load_lds((gptr_t*)(ap + (size_t)(32 * i) * lda), (lptr_t*)(lbase + i * 4096), 16, 0, 0);
    __builtin_amdgcn_global_load_lds((gptr_t*)(bp + (size_t)((lr + 32 * i) & (bvalid - 1)) * ldb), (lptr_t*)(lbase + 16384 + i * 4096), 16, 0, 0);
  }
}

DI void zero_acc(f32x4 (&acc)[4][4]) {
#pragma unroll
  for (int i = 0; i < 4; ++i)
#pragma unroll
    for (int j = 0; j < 4; ++j) acc[i][j] = f32x4{0.f, 0.f, 0.f, 0.f};
}


DI void stage_acc(const f32x4 (&acc)[4][4], float* tile, int wm, int wn, int fr, int fq) {
#pragma unroll
  for (int mi = 0; mi < 4; ++mi)
#pragma unroll
    for (int ni = 0; ni < 4; ++ni)
#pragma unroll
      for (int j = 0; j < 4; ++j) tile[(wm * 64 + mi * 16 + fq * 4 + j) * EPS + wn * 64 + ni * 16 + fr] = acc[mi][ni][j];
}
DI float row16_sum(float v) {
  v += __builtin_bit_cast(float, __builtin_amdgcn_update_dpp(0, __builtin_bit_cast(int, v), 0xB1, 0xf, 0xf, true));
  v += __builtin_bit_cast(float, __builtin_amdgcn_update_dpp(0, __builtin_bit_cast(int, v), 0x4E, 0xf, 0xf, true));
  v += __builtin_bit_cast(float, __builtin_amdgcn_update_dpp(0, __builtin_bit_cast(int, v), 0x141, 0xf, 0xf, true));
  v += __builtin_bit_cast(float, __builtin_amdgcn_update_dpp(0, __builtin_bit_cast(int, v), 0x140, 0xf, 0xf, true));
  return v;
}


struct XcdWalk {
  int MT, NT, x, mx, total, L, step;
  DI void init(int MT_, int NT_) {
    MT = MT_; NT = NT_;
    const int nb = gridDim.x >> 3;
    if ((gridDim.x & 7) == 0 && nb > 0) { x = blockIdx.x & 7; L = blockIdx.x >> 3; step = nb; mx = (MT - x + 7) >> 3; total = mx * NT; }
    else { x = -1; L = blockIdx.x; step = gridDim.x; mx = MT; total = MT * NT; }
  }
  DI bool next(int& mt, int& nt) {
    if (L >= total) return false;
    if (x < 0) { mt = L / NT; nt = L % NT; L += step; return true; }
    const int colsz = mx * 8;
    const int nfull = NT >> 3;
    int ng = L / colsz, gn = 8;
    if (ng >= nfull) { ng = nfull; gn = NT & 7; }
    const int Lp = L - ng * colsz;
    const int mg = Lp / (8 * gn), r = Lp - mg * 8 * gn;
    const int rows = (mx - 8 * mg) < 8 ? (mx - 8 * mg) : 8;
    const int lm = r / gn, ln = r - lm * gn;
    mt = (8 * mg + lm) * 8 + x; nt = ng * 8 + ln;
    L += step;
    return true;
  }
};

DI void tr_item(const float* __restrict__ src, int ldsrc, int k0, int n0, bf16_t* __restrict__ dst, int K, const float* __restrict__ gs, bool winmap, float* tile) {
  const int tid = tidx();
  const int kk = tid >> 4, n4 = (tid & 15) * 4;
#pragma unroll
  for (int i = 0; i < 4; ++i) {
    const int k = k0 + kk + 16 * i;
    const int nd = n0 + n4;
    int sn = nd;
    if (winmap) sn = (nd < 2856) ? nd : ((nd < 2880) ? -1 : nd - 24);
    f32x4 v = {0.f, 0.f, 0.f, 0.f};
    if (sn >= 0) v = *(const f32x4*)(src + (size_t)k * ldsrc + sn);
    if (gs) { const float g = gs[k]; v *= g; }
    float* t = tile + (kk + 16 * i) * 65 + n4;
    t[0] = v.x; t[1] = v.y; t[2] = v.z; t[3] = v.w;
  }
  __syncthreads();
  const int n = tid >> 2, kc = tid & 3;
  unsigned o[8];
#pragma unroll
  for (int e = 0; e < 8; ++e) o[e] = pk2(tile[(kc * 16 + 2 * e) * 65 + n], tile[(kc * 16 + 2 * e + 1) * 65 + n]);
  bf16_t* d = dst + (size_t)(n0 + n) * K + k0 + kc * 16;
  *(u32x4*)d = u32x4{o[0], o[1], o[2], o[3]};
  *(u32x4*)(d + 8) = u32x4{o[4], o[5], o[6], o[7]};
  __syncthreads();
}

DI void conv_cache_k(const P& p, int layer, int it) {
  const size_t e0 = ((size_t)it * 256 + tidx()) * 8;
  const int b = (int)(e0 / (4096ull * 512)), rem = (int)(e0 % (4096ull * 512));
  const float* s = p.cache_k + (size_t)layer * 8 * 4096 * 512 + e0;
  const f32x4 v0 = __builtin_nontemporal_load((const f32x4*)s), v1 = __builtin_nontemporal_load((const f32x4*)(s + 4));
  bf16_t* d = (bf16_t*)(p.ws + W_KS) + (size_t)b * LS * 512 + rem;
  *(u32x4*)d = u32x4{pk2(v0.x, v0.y), pk2(v0.z, v0.w), pk2(v1.x, v1.y), pk2(v1.z, v1.w)};
}
DI void conv_cache_v(const P& p, int layer, int it) {
  const int kg = it & 127, h = (it >> 7) & 7, b = it >> 10;
  const int d = tidx() & 63, ko = tidx() >> 6;
  const int key0 = kg * 32 + ko * 8;
  const float* s = p.cache_v + (size_t)layer * 8 * 4096 * 512 + ((size_t)(b * 4096 + key0) * 8 + h) * 64 + d;
  float v[8];
#pragma unroll
  for (int e = 0; e < 8; ++e) v[e] = __builtin_nontemporal_load(s + (size_t)e * 512);
  bf16_t* dst = (bf16_t*)(p.ws + W_VTS) + ((size_t)(b * 8 + h) * 64 + d) * LS + (key0 & ~15) + ((key0 & 8) >> 1);
  *(u32x2*)dst = u32x2{pk2(v[0], v[1]), pk2(v[2], v[3])};
  *(u32x2*)(dst + 8) = u32x2{pk2(v[4], v[5]), pk2(v[6], v[7])};
}
DI void conv_cache_ki(const P& p, int it) {
  const size_t e0 = ((size_t)it * 256 + tidx()) * 8;
  const int lb = (int)(e0 / (4096ull * 32)), rem = (int)(e0 % (4096ull * 32));
  const float* s = p.cache_ki + e0;
  const f32x4 v0 = __builtin_nontemporal_load((const f32x4*)s), v1 = __builtin_nontemporal_load((const f32x4*)(s + 4));
  bf16_t* d = (bf16_t*)(p.ws + W_KIS) + (size_t)lb * LS * 32 + rem;
  *(u32x4*)d = u32x4{pk2(v0.x, v0.y), pk2(v0.z, v0.w), pk2(v1.x, v1.y), pk2(v1.z, v1.w)};
}

DI void rope_item(const P& p, int it) {
  const int e = it * 256 + tidx();
  if (e >= LS * 48) return;
  const int pos = e / 48, i = e % 48;
  float inv;
  if (i < 32) inv = exp2f(-(float)(2 * i) / 64.f * 13.287712379549449f);
  else inv = exp2f(-(float)(2 * (i - 32)) / 32.f * 13.287712379549449f);
  const float ang = (float)pos * inv;
  const float n = rintf(ang * 0.15915494309189535f);
  float r = fmaf(-n, 6.28125f, ang);
  r = fmaf(-n, 1.9353071795864769e-3f, r);
  const float c = cosf(r), s = sinf(r);
  f32x2* dst = (i < 32) ? ((f32x2*)(p.ws + W_R64) + pos * 32 + i) : ((f32x2*)(p.ws + W_R32) + pos * 16 + (i - 32));
  *dst = f32x2{c, s};
}

DI void xconv_item(const P& p, int it) {
  const int lane = tidx() & 63, wave = __builtin_amdgcn_readfirstlane(tidx() >> 6);
  const int row = it * 4 + wave;
  const float* x = (row < NTP) ? (p.x_p + (size_t)row * DM) : (p.x_s + (size_t)(row - NTP) * DM);
  bf16_t* xb = (bf16_t*)(p.ws + W_XB) + (size_t)row * DM;
  float ss = 0.f;
#pragma unroll
  for (int j = 0; j < 4; ++j) {
    const f32x4 v = *(const f32x4*)(x + j * 256 + lane * 4);
    ss += v.x * v.x + v.y * v.y + v.z * v.z + v.w * v.w;
    *(u32x2*)(xb + j * 256 + lane * 4) = u32x2{pk2(v.x, v.y), pk2(v.z, v.w)};
  }
  ss = wave_sum(ss);
  if (lane < 16) ((float*)(p.ws + W_SS))[(size_t)row * 16 + lane] = (lane == 0) ? ss : 0.f;
}

constexpr int NWITEM = 16 * 85 + 128 + 128 + 256 + 16;
DI void weight_item(const P& p, int l, int idx, float* tile) {
  if (idx < 16 * 85) {
    const int kt = idx / 85, nt = idx % 85;
    tr_item(p.w_in + (size_t)l * 1024 * NCOL, NCOL, kt * 64, nt * 64, (bf16_t*)(p.ws + W_WIN) + (size_t)l * NP * 1024, 1024, p.norm_g + l * 1024, true, tile);
  } else if (idx < 16 * 85 + 128) {
    const int r = idx - 16 * 85, kt = r / 16, nt = r % 16;
    tr_item(p.w_po + (size_t)l * 512 * 1024, 1024, kt * 64, nt * 64, (bf16_t*)(p.ws + W_WPO) + (size_t)l * 1024 * 512, 512, nullptr, false, tile);
  } else if (idx < 16 * 85 + 256) {
    const int r = idx - 16 * 85 - 128, kt = r / 16, nt = r % 16;
    tr_item(p.w_ao + (size_t)l * 512 * 1024, 1024, kt * 64, nt * 64, (bf16_t*)(p.ws + W_WAO) + (size_t)l * 1024 * 512, 512, nullptr, false, tile);
  } else if (idx < 16 * 85 + 512) {
    const int r = idx - 16 * 85 - 256, kt = r / 16, nt = r % 16;
    tr_item(p.w_o + (size_t)l * 1024 * 1024, 1024, kt * 64, nt * 64, (bf16_t*)(p.ws + W_WO) + (size_t)l * 1024 * LDX, LDX, nullptr, false, tile);
  } else {
    const int r0 = idx - 16 * 85 - 512, g = r0 / 4, r = r0 % 4, kt = r / 2, nt = r % 2;
    tr_item(p.w_mix + (size_t)(l * 4 + g) * 128 * 128, 128, kt * 64, nt * 64, (bf16_t*)(p.ws + W_WMIX) + (size_t)(l * 4 + g) * 128 * 128, 128, nullptr, false, tile);
  }
}

PHASE_FN void phase0(const P& p, char* lds) {
  float* tile = (float*)lds;
  constexpr int R4 = NWITEM, R5 = R4 + 8320, R6 = R5 + 780, R9 = R6 + 1024;
  for (int it = blockIdx.x; it < R9; it += gridDim.x) {
    if (it < R4) weight_item(p, 0, it, tile);
    else if (it < R5) xconv_item(p, it - R4);
    else if (it < R6) rope_item(p, it - R5);
    else conv_cache_ki(p, it - R6);
  }
}

DI void phaseA_tile(const P& p, int layer, int mt, int nt, char* lds) {
  const int tid = tidx(), lane = tid & 63, wave = __builtin_amdgcn_readfirstlane(tid >> 6);
  const int row0 = mt * 128, col0 = nt * 128;
  const int bvalid = (NP - col0) < 128 ? 64 : 128;
  float* rr = (float*)(lds + RR_OFF);
  __syncthreads();
  const float* sp = (const float*)(p.ws + W_SS) + (size_t)(row0 + (tid & 127)) * 16;
  const f32x4 ssa = *(const f32x4*)sp, ssb = *(const f32x4*)(sp + 4), ssc = *(const f32x4*)(sp + 8), ssd = *(const f32x4*)(sp + 12);
  f32x4 acc[4][4];
  zero_acc(acc);
  gemm_tile((const bf16_t*)(p.ws + W_XB) + (size_t)row0 * DM, DM, (const bf16_t*)(p.ws + W_WIN) + ((size_t)layer * NP + col0) * 1024, 1024, bvalid, 1024, acc, lds);
  const int wm = wave >> 1, wn = wave & 1;
  const int seg = (col0 >> 6) + wn;
  const int fr = lane & 15, fq = lane >> 4;
  if (tid < 128) {
    const float ss = (ssa.x + ssa.y + ssa.z + ssa.w) + (ssb.x + ssb.y + ssb.z + ssb.w) + (ssc.x + ssc.y + ssc.z + ssc.w) + (ssd.x + ssd.y + ssd.z + ssd.w);
    rr[tid] = rsqrtf(ss * (1.f / 1024.f) + 1e-6f);
  }
  float* stg = (float*)lds;
  stage_acc(acc, stg, wm, wn, fr, fq);
  __syncthreads();
  if (seg >= NSEG) return;
  float* out = p.out;
  const bool isS = row0 >= NTP;
  if (seg >= 53) {
    const bool isP = seg < 69;
    unsigned* G = (unsigned*)(p.ws + (isP ? W_GP : W_GA)) + ((size_t)(((row0 >> 6) + wm) * 16 + (isP ? seg - 53 : seg - 69)) * 64 + lane) * 16;
#pragma unroll
    for (int mi = 0; mi < 4; ++mi) {
      unsigned wv[4];
#pragma unroll
      for (int ni = 0; ni < 4; ++ni) {
        unsigned w_ = 0u;
#pragma unroll
        for (int j = 0; j < 4; ++j) {
          const float r = rr[wm * 64 + mi * 16 + fq * 4 + j];
          w_ |= ((unsigned)(int)(sigmoidf_(acc[mi][ni][j] * r) * 255.f + 0.5f)) << (8 * j);
        }
        wv[ni] = w_;
      }
      *(u32x4*)(G + mi * 4) = u32x4{wv[0], wv[1], wv[2], wv[3]};
    }
    return;
  }
  if (seg >= 32 && seg < 40) {
    const int h = seg - 32;
    const int wrow0 = row0 + wm * 64;
    const int bb = isS ? ((wrow0 - NTP) >> 6) : (wrow0 >> 11);
    const int tb = isS ? 0 : (wrow0 & 2047);
#pragma unroll
    for (int mi = 0; mi < 4; ++mi) {
      const int lr0 = mi * 16 + fq * 4, t0 = tb + mi * 16 + ((((fq & 1) << 1) | (fq >> 1)) << 2);
      const f32x4 r4 = *(const f32x4*)(rr + wm * 64 + lr0);
#pragma unroll
      for (int ni = 0; ni < 4; ++ni) {
        const int d = ni * 16 + fr;
        const f32x4 v = acc[mi][ni] * r4;
        bf16_t* vt = isS ? (bf16_t*)(p.ws + W_VTS) + ((size_t)(bb * 8 + h) * 64 + d) * LS + PAST + t0 : (bf16_t*)(p.ws + W_VTP) + ((size_t)(bb * 8 + h) * 64 + d) * TP + t0;
        *(u32x2*)vt = u32x2{pk2(v.x, v.y), pk2(v.z, v.w)};
      }
    }
  }
  const int cc = lane & 15;
  const bool rope64 = seg >= 16 && seg < 32, rope32 = seg >= 40 && seg <= 44;
  if (rope64 || rope32) {
    const int pair = rope64 ? 8 : 4, fmask = rope64 ? 7 : 3;
    const float* RT = (const float*)(p.ws + (rope64 ? W_R64 : W_R32));
    const int rstride = rope64 ? 32 : 16;
    const float sg = (cc & pair) ? 1.f : -1.f;
#pragma unroll 1
    for (int half = 0; half < 2; ++half) {
      f32x4 c0[8], c1[8];
#pragma unroll
      for (int pq = 0; pq < 8; ++pq) {
        const int row = row0 + (half * 8 + pq) * 8 + wm * 4 + fq;
        const int t = isS ? ((row - NTP) & 63) : (row & 2047);
        const float* cs = RT + ((size_t)(isS ? PAST + t : t) * rstride + (cc & fmask) * 4) * 2;
        c0[pq] = *(const f32x4*)cs; c1[pq] = *(const f32x4*)(cs + 4);
      }
#pragma unroll
      for (int pq = 0; pq < 8; ++pq) {
        const int lr = (half * 8 + pq) * 8 + wm * 4 + fq, row = row0 + lr;
        const float r = rr[lr];
        const float* tp = stg + lr * EPS + wn * 64;
        const f32x4 v = *(const f32x4*)(tp + cc * 4) * r;
        const f32x4 pv = *(const f32x4*)(tp + (cc ^ pair) * 4) * r;
        const int bb = isS ? ((row - NTP) >> 6) : (row >> 11);
        const int t = isS ? ((row - NTP) & 63) : (row & 2047);
        f32x4 o;
        o.x = v.x * c0[pq].x + sg * pv.x * c0[pq].y; o.y = v.y * c0[pq].z + sg * pv.y * c0[pq].w;
        o.z = v.z * c1[pq].x + sg * pv.z * c1[pq].y; o.w = v.w * c1[pq].z + sg * pv.w * c1[pq].w;
        if (seg < 24) {
          *(u32x2*)((bf16_t*)(p.ws + W_Q) + (size_t)row * 512 + (seg - 16) * 64 + cc * 4) = u32x2{pk2(o.x * QSCALE, o.y * QSCALE), pk2(o.z * QSCALE, o.w * QSCALE)};
        } else if (seg < 32) {
          const int hc = (seg - 24) * 64 + cc * 4;
          float* ko = isS ? out + O_KS + ((size_t)(layer * 8 + bb) * TS + t) * 512 + hc : out + O_KP + ((size_t)(layer * 16 + bb) * TP + t) * 512 + hc;
          bf16_t* kb = isS ? (bf16_t*)(p.ws + W_KS) + ((size_t)bb * LS + PAST + t) * 512 + hc : (bf16_t*)(p.ws + W_KP) + ((size_t)bb * TP + t) * 512 + hc;
          __builtin_nontemporal_store(o, (f32x4*)ko);
          *(u32x2*)kb = u32x2{pk2(o.x, o.y), pk2(o.z, o.w)};
        } else if (seg < 44) {
          *(u32x2*)((bf16_t*)(p.ws + W_QI) + (size_t)row * 256 + (seg - 40) * 64 + cc * 4) = u32x2{pk2(o.x, o.y), pk2(o.z, o.w)};
        } else if (cc < 8) {
          float* ko = isS ? out + O_KIS + ((size_t)(layer * 8 + bb) * TS + t) * 32 + cc * 4 : out + O_KIP + ((size_t)(layer * 16 + bb) * TP + t) * 32 + cc * 4;
          bf16_t* kb = isS ? (bf16_t*)(p.ws + W_KIS) + ((size_t)(layer * 8 + bb) * LS + PAST + t) * 32 + cc * 4 : (bf16_t*)(p.ws + W_KIP) + ((size_t)bb * TP + t) * 32 + cc * 4;
          __builtin_nontemporal_store(o, (f32x4*)ko);
          *(u32x2*)kb = u32x2{pk2(o.x, o.y), pk2(o.z, o.w)};
        } else if (cc < 10) {
          *(f32x4*)((float*)(p.ws + W_WI) + (size_t)row * 8 + (cc - 8) * 4) = v * 0.0625f;
        }
      }
    }
    return;
  }
#pragma unroll 2
  for (int ps = 0; ps < 16; ++ps) {
    const int lr = ps * 8 + wm * 4 + fq, row = row0 + lr;
    const float r = rr[lr];
    const float* tp = stg + lr * EPS + wn * 64;
    const f32x4 v = *(const f32x4*)(tp + cc * 4) * r;
    const int bb = isS ? ((row - NTP) >> 6) : (row >> 11);
    const int t = isS ? ((row - NTP) & 63) : (row & 2047);
    if (seg < 8) {
      const int col = seg * 64 + cc * 4;
      *(u32x2*)((bf16_t*)(p.ws + W_U) + (size_t)row * 512 + col) = u32x2{pk2(v.x, v.y), pk2(v.z, v.w)};
      if (!isS) { if (t >= TP - 15) *(f32x4*)(out + O_PP + ((size_t)(layer * 16 + bb) * 15 + (t - (TP - 15))) * 512 + col) = v; }
      else { if (t >= TS - 15) *(f32x4*)(out + O_PS + ((size_t)(layer * 8 + bb) * 15 + (t - (TS - 15))) * 512 + col) = v; }
    } else if (seg < 16 || (seg >= 45 && seg < 53)) {
      bf16_t* Z = (bf16_t*)(p.ws + (seg < 16 ? W_ZP : W_ZA)) + (size_t)row * 512 + (seg < 16 ? seg - 8 : seg - 45) * 64 + cc * 4;
      *(u32x2*)Z = u32x2{pk2(siluf_(v.x), siluf_(v.y)), pk2(siluf_(v.z), siluf_(v.w))};
    } else {
      const int hc = (seg - 32) * 64 + cc * 4;
      float* vo = isS ? out + O_VS + ((size_t)(layer * 8 + bb) * TS + t) * 512 + hc : out + O_VP + ((size_t)(layer * 16 + bb) * TP + t) * 512 + hc;
      __builtin_nontemporal_store(v, (f32x4*)vo);
    }
  }
}


DI int next_ticket(unsigned* ctr, int* slot) {
  __syncthreads();
  if (__builtin_amdgcn_workitem_id_x() == 0) *slot = (int)__hip_atomic_fetch_add(ctr, 1u, __ATOMIC_RELAXED, __HIP_MEMORY_SCOPE_AGENT);
  __syncthreads();
  return *slot;
}

DI int wave_isum(int v) {
  v += __builtin_amdgcn_update_dpp(0, v, 0xB1, 0xf, 0xf, true);
  v += __builtin_amdgcn_update_dpp(0, v, 0x4E, 0xf, 0xf, true);
  v += __builtin_amdgcn_update_dpp(0, v, 0x141, 0xf, 0xf, true);
  v += __builtin_amdgcn_update_dpp(0, v, 0x140, 0xf, 0xf, true);
  return __builtin_amdgcn_readlane(v, 0) + __builtin_amdgcn_readlane(v, 16) + __builtin_amdgcn_readlane(v, 32) + __builtin_amdgcn_readlane(v, 48);
}

DI unsigned wave_umax(unsigned v) {
  unsigned t;
  t = (unsigned)__builtin_amdgcn_update_dpp(0, (int)v, 0xB1, 0xf, 0xf, true); v = t > v ? t : v;
  t = (unsigned)__builtin_amdgcn_update_dpp(0, (int)v, 0x4E, 0xf, 0xf, true); v = t > v ? t : v;
  t = (unsigned)__builtin_amdgcn_update_dpp(0, (int)v, 0x141, 0xf, 0xf, true); v = t > v ? t : v;
  t = (unsigned)__builtin_amdgcn_update_dpp(0, (int)v, 0x140, 0xf, 0xf, true); v = t > v ? t : v;
  const unsigned a = (unsigned)__builtin_amdgcn_readlane((int)v, 0), b = (unsigned)__builtin_amdgcn_readlane((int)v, 16);
  const unsigned c = (unsigned)__builtin_amdgcn_readlane((int)v, 32), d = (unsigned)__builtin_amdgcn_readlane((int)v, 48);
  const unsigned ab = a > b ? a : b, cd = c > d ? c : d;
  return ab > cd ? ab : cd;
}

template <bool SAMPLE>
DI void b1_score(const bf16_t* __restrict__ QI, const float* __restrict__ WI, const bf16_t* __restrict__ KI, int qrow0, int nt, float* sc, int pass) {
  const int lane = tidx() & 63, r = lane & 31, hl = lane >> 5;
  const int rp = r & 15, hq = (rp >> 2) & 1, head = (rp & 3) + 4 * (rp >> 3);
  const bf16_t* qa = QI + (size_t)(qrow0 + hq) * 256 + head * 32 + 8 * hl;
  const bf16x8 a0 = *(const bf16x8*)qa, a1 = *(const bf16x8*)(qa + 16);
  const float* wp = WI + (size_t)(qrow0 + hl) * 8;
  const f32x4 w0 = *(const f32x4*)wp, w1 = *(const f32x4*)(wp + 4);
  const bf16_t* kb = KI + (size_t)r * 32 + 8 * hl;
  bf16x8 c[4], n[4];
  c[0] = *(const bf16x8*)(kb); c[1] = *(const bf16x8*)(kb + 16); c[2] = *(const bf16x8*)(kb + 1024); c[3] = *(const bf16x8*)(kb + 1024 + 16);
  float* so = SAMPLE ? sc + r : sc + hl * 2048 + r;
  const int ng = nt >> 1;
#pragma unroll 1
  for (int g = 0; g < ng; ++g) {
    const int gn = (g + 1 < ng) ? g + 1 : g;
    const bf16_t* kn = kb + (size_t)gn * 2048;
    n[0] = *(const bf16x8*)(kn); n[1] = *(const bf16x8*)(kn + 16); n[2] = *(const bf16x8*)(kn + 1024); n[3] = *(const bf16x8*)(kn + 1024 + 16);
#pragma unroll
    for (int tt = 0; tt < 2; ++tt) {
      f32x16 acc;
#pragma unroll
      for (int i = 0; i < 16; ++i) acc[i] = 0.f;
      acc = MFMA32(a0, c[2 * tt], acc);
      acc = MFMA32(a1, c[2 * tt + 1], acc);
      float s_ = 0.f;
      s_ = fmaf(w0.x, fmaxf(acc[0], 0.f), s_); s_ = fmaf(w0.y, fmaxf(acc[1], 0.f), s_); s_ = fmaf(w0.z, fmaxf(acc[2], 0.f), s_); s_ = fmaf(w0.w, fmaxf(acc[3], 0.f), s_);
      s_ = fmaf(w1.x, fmaxf(acc[4], 0.f), s_); s_ = fmaf(w1.y, fmaxf(acc[5], 0.f), s_); s_ = fmaf(w1.z, fmaxf(acc[6], 0.f), s_); s_ = fmaf(w1.w, fmaxf(acc[7], 0.f), s_);
      if (!SAMPLE || hl == pass) so[(2 * g + tt) * 32] = s_;
    }
#pragma unroll
    for (int i = 0; i < 4; ++i) c[i] = n[i];
  }
}

template <bool SAMPLE>
DI void b1_score_coop(const bf16_t* __restrict__ QI, const float* __restrict__ WI, const bf16_t* __restrict__ KI, int qrow0, int nt, float* scb, int rowlen, int wave) {
  constexpr int NSET = SAMPLE ? 1 : 2;
  const int lane = tidx() & 63, r = lane & 31, hl = lane >> 5;
  const int rp = r & 15, hq = (rp >> 2) & 1, head = (rp & 3) + 4 * (rp >> 3), slr = r >> 4;
  bf16x8 a0[NSET], a1[NSET];
  float w[NSET][2][8];
#pragma unroll
  for (int s_ = 0; s_ < NSET; ++s_) {
    const bf16_t* qa = QI + (size_t)(qrow0 + 4 * s_ + 2 * slr + hq) * 256 + head * 32 + 8 * hl;
    a0[s_] = *(const bf16x8*)qa; a1[s_] = *(const bf16x8*)(qa + 16);
#pragma unroll
    for (int sl = 0; sl < 2; ++sl) {
      const float* wp = WI + (size_t)(qrow0 + 4 * s_ + 2 * sl + hl) * 8;
      const f32x4 w0 = *(const f32x4*)wp, w1 = *(const f32x4*)(wp + 4);
      w[s_][sl][0] = w0.x; w[s_][sl][1] = w0.y; w[s_][sl][2] = w0.z; w[s_][sl][3] = w0.w;
      w[s_][sl][4] = w1.x; w[s_][sl][5] = w1.y; w[s_][sl][6] = w1.z; w[s_][sl][7] = w1.w;
    }
  }
  const bf16_t* kb = KI + (size_t)r * 32 + 8 * hl;
  const int ng = nt >> 1;
  bf16x8 c[4], n[4];
  if (wave < ng) { const bf16_t* k0 = kb + (size_t)wave * 2048; c[0] = *(const bf16x8*)(k0); c[1] = *(const bf16x8*)(k0 + 16); c[2] = *(const bf16x8*)(k0 + 1024); c[3] = *(const bf16x8*)(k0 + 1024 + 16); }
#pragma unroll 1
  for (int g = wave; g < ng; g += 4) {
    const int gn = (g + 4 < ng) ? g + 4 : g;
    const bf16_t* kn = kb + (size_t)gn * 2048;
    n[0] = *(const bf16x8*)(kn); n[1] = *(const bf16x8*)(kn + 16); n[2] = *(const bf16x8*)(kn + 1024); n[3] = *(const bf16x8*)(kn + 1024 + 16);
#pragma unroll
    for (int tt = 0; tt < 2; ++tt)
#pragma unroll
      for (int s_ = 0; s_ < NSET; ++s_) {
        f32x16 acc;
#pragma unroll
        for (int i = 0; i < 16; ++i) acc[i] = 0.f;
        acc = MFMA32(a0[s_], c[2 * tt], acc);
        acc = MFMA32(a1[s_], c[2 * tt + 1], acc);
#pragma unroll
        for (int sl = 0; sl < 2; ++sl) {
          float x0 = 0.f, x1 = 0.f;
#pragma unroll
          for (int i = 0; i < 4; ++i) { x0 = fmaf(w[s_][sl][i], fmaxf(acc[8 * sl + i], 0.f), x0); x1 = fmaf(w[s_][sl][4 + i], fmaxf(acc[8 * sl + 4 + i], 0.f), x1); }
          scb[(4 * s_ + 2 * sl + hl) * rowlen + (2 * g + tt) * 32 + r] = x0 + x1;
        }
      }
#pragma unroll
    for (int i = 0; i < 4; ++i) c[i] = n[i];
  }
}

template <int NJ>
DI void b1_select(const float* sc, int nj, unsigned* mo) {
  const int lane = tidx() & 63;
  unsigned key[NJ];
#pragma unroll
  for (int j = 0; j < NJ; ++j) {
    unsigned k = 0u;
    if (j < nj) {
      unsigned u = __float_as_uint(sc[64 * j + lane]);
      u = (u == 0x80000000u) ? 0u : u;
      k = (u & 0x80000000u) ? ~u : (u | 0x80000000u);
    }
    key[j] = k;
  }
  unsigned mloc = 0u;
#pragma unroll
  for (int j = 0; j < NJ; ++j) mloc = key[j] > mloc ? key[j] : mloc;
  const unsigned M = wave_umax(mloc);
  unsigned T = 0u;
  int bit = 31;
  bool exact = false;
  {
    unsigned E = M >> 23;
#pragma unroll 1
    for (int i = 0; i < 8; ++i) {
      const unsigned cand = E << 23;
      int c0 = 0, c1 = 0;
#pragma unroll
      for (int j = 0; j < NJ; ++j) { if (j & 1) c1 += (key[j] >= cand) ? 1 : 0; else c0 += (key[j] >= cand) ? 1 : 0; }
      const int cnt = wave_isum(c0 + c1);
      if (cnt >= 256) { T = cand; bit = 22; exact = (cnt == 256); break; }
      if (E == 0u) break;
      --E;
    }
  }
  if (!exact) {
#pragma unroll 1
    for (; bit >= 0; --bit) {
      const unsigned cand = T | (1u << bit);
      int c0 = 0, c1 = 0;
#pragma unroll
      for (int j = 0; j < NJ; ++j) { if (j & 1) c1 += (key[j] >= cand) ? 1 : 0; else c0 += (key[j] >= cand) ? 1 : 0; }
      const int cnt = wave_isum(c0 + c1);
      if (cnt >= 256) { T = cand; if (cnt == 256) break; }
    }
  }
  int cgt = 0;
#pragma unroll
  for (int j = 0; j < NJ; ++j) cgt += __popcll(__ballot(key[j] > T));
  const int need = 256 - cgt;
  const unsigned long long lm = (1ull << lane) - 1ull;
  int run = 0;
  unsigned long long w0 = 0ull, w1 = 0ull;
#pragma unroll
  for (int j = 0; j < NJ; ++j) {
    const bool e = key[j] == T;
    const unsigned long long me = __ballot(e);
    const int before = run + __popcll(me & lm);
    const bool sel = (key[j] > T) || (e && before < need);
    run += __popcll(me);
    const unsigned long long ms = __ballot(sel);
    if (j < 64) w0 = (lane == j) ? ms : w0; else w1 = (lane == j - 64) ? ms : w1;
  }
  if (NJ >= 64 || lane < NJ) *(u32x2*)(mo + 2 * lane) = u32x2{(unsigned)w0, (unsigned)(w0 >> 32)};
  if (NJ > 64 && lane < NJ - 64) *(u32x2*)(mo + 128 + 2 * lane) = u32x2{(unsigned)w1, (unsigned)(w1 >> 32)};
}

DI void pooled_item(const P& p, int layer, int it) {
  const int row = it * 4 + __builtin_amdgcn_readfirstlane(tidx() >> 6), c0 = (tidx() & 63) * 8;
  const int g = c0 >> 7, w = 2 << g;
  const bool isS = row >= NTP;
  const int b = isS ? ((row - NTP) >> 6) : (row >> 11), t = isS ? ((row - NTP) & 63) : (row & 2047);
  const bf16_t* U = (const bf16_t*)(p.ws + W_U);
  u32x4 uv[16];
#pragma unroll
  for (int j = 0; j < 16; ++j) {
    uv[j] = u32x4{0u, 0u, 0u, 0u};
    if (j < w && t - j >= 0) uv[j] = *(const u32x4*)(U + (size_t)(row - j) * 512 + c0);
  }
  float s[8];
#pragma unroll
  for (int e = 0; e < 8; ++e) s[e] = 0.f;
#pragma unroll
  for (int j = 0; j < 16; ++j)
#pragma unroll
    for (int e = 0; e < 4; ++e) { s[2 * e] += __uint_as_float(uv[j][e] << 16); s[2 * e + 1] += __uint_as_float(uv[j][e] & 0xffff0000u); }
  if (isS && t < 15) {
    for (int j = t + 1; j < w; ++j) {
      const float* lp = p.state_pool + ((size_t)(layer * 8 + b) * 15 + (15 + t - j)) * 512 + c0;
      const f32x4 v0 = *(const f32x4*)lp, v1 = *(const f32x4*)(lp + 4);
      s[0] += v0.x; s[1] += v0.y; s[2] += v0.z; s[3] += v0.w; s[4] += v1.x; s[5] += v1.y; s[6] += v1.z; s[7] += v1.w;
    }
  }
  const float inv = 1.f / (float)(isS ? w : ((t + 1) < w ? (t + 1) : w));
  unsigned o[4];
#pragma unroll
  for (int e = 0; e < 4; ++e) o[e] = pk2(s[2 * e] * inv - __uint_as_float(uv[0][e] << 16), s[2 * e + 1] * inv - __uint_as_float(uv[0][e] & 0xffff0000u));
  *(u32x4*)((bf16_t*)(p.ws + W_POOLED) + (size_t)row * 512 + c0) = u32x4{o[0], o[1], o[2], o[3]};
}

PHASE_FN void phaseB(const P& p, int layer, char* lds) {
  constexpr int NB1S = 128, NB1P = 4096, NPG = 8320 / 8, NCK = 8192 / 8, NCV = 8192 / 8, NWG = NWITEM / 8;
  static_assert(NWITEM % 8 == 0 && NPG + NCK + NCV + NWG <= NB1P, "interleave assumes fewer misc groups than prompt items");
  const int NMISC = NPG + NCK + NCV + (layer == 0 ? NWG : 0);
  const int NTICK = NB1S + 2 * NMISC + (NB1P - NMISC);
  const int wave = __builtin_amdgcn_readfirstlane(tidx() >> 6), lane = tidx() & 63;
  float* scb = (float*)lds;
  const bf16_t* QI = (const bf16_t*)(p.ws + W_QI);
  const float* WI = (const float*)(p.ws + W_WI);
  unsigned* ctr = (unsigned*)(p.ws + W_BAR) + 3520 + layer * 64;
  int* slot = (int*)(lds + RR_OFF + 496);
  for (;;) {
    const int it = next_ticket(ctr, slot);
    if (it >= NTICK) break;
    int pi = -1, mi = -1;
    if (it >= NB1S) {
      const int t = it - NB1S;
      if (t < 2 * NMISC) { if (t & 1) mi = t >> 1; else pi = t >> 1; }
      else pi = t - NMISC;
    }
    if (it < NB1S) {
      const int srow = 4 * it, b = srow >> 6;
      const bf16_t* KI = (const bf16_t*)(p.ws + W_KIS) + (size_t)(layer * 8 + b) * LS * 32;
      b1_score_coop<true>(QI, WI, KI, NTP + srow, 130, scb, LS, wave);
      __syncthreads();
      b1_select<65>(scb + wave * LS, 65, (unsigned*)(p.ws + W_MASKS) + (size_t)(srow + wave) * 192);
    } else if (pi >= 0) {
      const int i0 = pi * 4;
      const int chunk = 31 - (i0 >> 9), b = (i0 & 511) >> 5, sub0 = i0 & 31;
      const int row0 = b * TP + chunk * 64 + sub0 * 2, row = row0 + 2 * wave, nt = 2 * (chunk + 1);
      unsigned* mo = (unsigned*)(p.ws + W_MASKP) + (size_t)row * 64;
      if (nt * 32 <= 256) {
        if (lane < 32) {
          const unsigned v = (lane < (nt >> 1)) ? 0xffffffffu : 0u;
          *(u32x2*)(mo + 2 * lane) = u32x2{v, v};
          *(u32x2*)(mo + 64 + 2 * lane) = u32x2{v, v};
        }
      } else {
        b1_score_coop<false>(QI, WI, (const bf16_t*)(p.ws + W_KIP) + (size_t)b * TP * 32, row0, nt, scb, 2048, wave);
        __syncthreads();
        const int nj = nt >> 1;
#define SEL2(N_) { b1_select<N_>(scb + (2 * wave) * 2048, nj, mo); b1_select<N_>(scb + (2 * wave + 1) * 2048, nj, mo + 64); }
        switch ((nj + 3) >> 2) {
          case 2: SEL2(8) break;
          case 3: SEL2(12) break;
          case 4: SEL2(16) break;
          case 5: SEL2(20) break;
          case 6: SEL2(24) break;
          case 7: SEL2(28) break;
          default: SEL2(32) break;
        }
#undef SEL2
      }
    } else if (mi < NPG) {
      for (int k = 0; k < 8; ++k) pooled_item(p, layer, mi * 8 + k);
    } else if (mi < NPG + NCK) {
      for (int k = 0; k < 8; ++k) conv_cache_k(p, layer, (mi - NPG) * 8 + k);
    } else if (mi < NPG + NCK + NCV) {
      for (int k = 0; k < 8; ++k) conv_cache_v(p, layer, (mi - NPG - NCK) * 8 + k);
    } else {
      for (int k = 0; k < 8; ++k) weight_item(p, 1, (mi - NPG - NCK - NCV) * 8 + k, (float*)lds);
    }
  }
}

DI void attn_item(const P& p, bool isS, int b, int h, int qblk, char* lds) {
  const int tid = tidx(), lane = tid & 63, wave = __builtin_amdgcn_readfirstlane(tid >> 6);
  const int r = lane & 31, hl = lane >> 5;
  int qbase, nkt, L, MW; const bf16_t *Kb, *Vb; const unsigned* Mb;
  if (isS) {
    qbase = NTP + b * 64; nkt = 65; L = LS; MW = 192;
    Kb = (const bf16_t*)(p.ws + W_KS) + (size_t)b * LS * 512 + h * 64;
    Vb = (const bf16_t*)(p.ws + W_VTS) + (size_t)(b * 8 + h) * 64 * LS;
    Mb = (const unsigned*)(p.ws + W_MASKS) + (size_t)(b * 64) * 192;
  } else {
    qbase = b * TP + qblk * 128; nkt = 2 * qblk + 2; L = TP; MW = 64;
    Kb = (const bf16_t*)(p.ws + W_KP) + (size_t)b * TP * 512 + h * 64;
    Vb = (const bf16_t*)(p.ws + W_VTP) + (size_t)(b * 8 + h) * 64 * TP;
    Mb = (const unsigned*)(p.ws + W_MASKP) + (size_t)qbase * 64;
  }
  const bool wvalid = !isS || wave < 2;
  const int ql = wvalid ? wave * 32 + r : r;
  const int qrow = qbase + ql;
  const bf16_t* qp = (const bf16_t*)(p.ws + W_Q) + (size_t)qrow * 512 + h * 64 + 8 * hl;
  bf16x8 qf[4];
#pragma unroll
  for (int s = 0; s < 4; ++s) qf[s] = *(const bf16x8*)(qp + 16 * s);
  const unsigned* mrow = Mb + (size_t)ql * MW;
  const int lr = tid >> 3, lc = tid & 7;
  const int swk = (lc ^ ((lr >> 1) & 7)) << 4;
  u32x4 rk0[2], rv0[2], rk1[2], rv1[2];
  u32x2 mwA, mwB, mwC;
#define AGL(rk, rv, mwx, kt_)                                                                  \
  _Pragma("unroll") for (int i = 0; i < 2; ++i) {                                              \
    rk[i] = *(const u32x4*)(Kb + (size_t)((kt_) * 64 + lr + 32 * i) * 512 + lc * 8);           \
    rv[i] = *(const u32x4*)(Vb + (size_t)(lr + 32 * i) * L + (kt_) * 64 + lc * 8);             \
  }                                                                                            \
  mwx = *(const u32x2*)(mrow + 2 * (kt_));
#define ALS(rk, rv, st_)                                                                       \
  _Pragma("unroll") for (int i = 0; i < 2; ++i) {                                              \
    const int row = lr + 32 * i;                                                               \
    *(u32x4*)(lds + (st_) * 16384 + row * 128 + swk) = rk[i];                                  \
    *(u32x4*)(lds + (st_) * 16384 + 8192 + row * 128 + swk) = rv[i];                           \
  }
  f32x16 ot[2];
#pragma unroll
  for (int i = 0; i < 16; ++i) { ot[0][i] = 0.f; ot[1][i] = 0.f; }
  float mrun = -1e30f, lsum = 0.f;
  const int fxk = (r >> 1) & 7;
  auto tile_compute = [&](const char* base, const u32x2 mw) {
    f32x16 st[2];
    bf16x8 kf[2][4];
#pragma unroll
    for (int kb = 0; kb < 2; ++kb)
#pragma unroll
      for (int s = 0; s < 4; ++s) kf[kb][s] = *(const bf16x8*)(base + (kb * 32 + r) * 128 + (((2 * s + hl) ^ fxk) << 4));
    __builtin_amdgcn_s_setprio(1);
#pragma unroll
    for (int kb = 0; kb < 2; ++kb) {
#pragma unroll
      for (int i = 0; i < 16; ++i) st[kb][i] = 0.f;
#pragma unroll
      for (int s = 0; s < 4; ++s) st[kb] = MFMA32(kf[kb][s], qf[s], st[kb]);
    }
    __builtin_amdgcn_s_setprio(0);
    float tmax = -INFINITY;
#pragma unroll
    for (int kb = 0; kb < 2; ++kb) {
      const unsigned wk = mw[kb] >> (4 * hl);
#pragma unroll
      for (int i = 0; i < 16; ++i) {
        const int bit = (i & 3) + 8 * (i >> 2);
        const float v = ((wk >> bit) & 1u) ? st[kb][i] : -INFINITY;
        st[kb][i] = v;
        tmax = fmaxf(tmax, v);
      }
    }
    if (__any(tmax - mrun > 32.f)) {
      const float mnew = fmaxf(mrun, fmaxf(tmax, __shfl_xor(tmax, 32)));
      const float alpha = __builtin_amdgcn_exp2f(mrun - mnew);
      mrun = mnew;
      lsum *= alpha;
#pragma unroll
      for (int i = 0; i < 16; ++i) { ot[0][i] *= alpha; ot[1][i] *= alpha; }
    }
    f32x2 ps2 = {0.f, 0.f};
#pragma unroll
    for (int kb = 0; kb < 2; ++kb)
#pragma unroll
      for (int i = 0; i < 16; i += 2) {
        const float p0 = __builtin_amdgcn_exp2f(st[kb][i] - mrun), p1 = __builtin_amdgcn_exp2f(st[kb][i + 1] - mrun);
        st[kb][i] = p0; st[kb][i + 1] = p1;
        ps2 += f32x2{p0, p1};
      }
    lsum += ps2.x + ps2.y;
#pragma unroll
    for (int kb = 0; kb < 2; ++kb)
#pragma unroll
      for (int s2 = 0; s2 < 2; ++s2) {
        const u32x4 pp = u32x4{pk2(st[kb][8 * s2 + 0], st[kb][8 * s2 + 1]), pk2(st[kb][8 * s2 + 2], st[kb][8 * s2 + 3]),
                               pk2(st[kb][8 * s2 + 4], st[kb][8 * s2 + 5]), pk2(st[kb][8 * s2 + 6], st[kb][8 * s2 + 7])};
        const bf16x8 pf = __builtin_bit_cast(bf16x8, pp);
        const int c1 = 2 * (2 * kb + s2) + hl;
#pragma unroll
        for (int db = 0; db < 2; ++db) {
          const bf16x8 vf = *(const bf16x8*)(base + 8192 + (db * 32 + r) * 128 + ((c1 ^ fxk) << 4));
          ot[db] = MFMA32(vf, pf, ot[db]);
        }
      }
  };
  __syncthreads();
  AGL(rk0, rv0, mwA, 0)
  if (nkt > 1) { AGL(rk1, rv1, mwB, 1) }
  ALS(rk0, rv0, 0)
  __syncthreads();
  for (int kt = 0; kt < nkt; kt += 2) {
    if (kt + 2 < nkt) { AGL(rk0, rv0, mwC, kt + 2) }
    tile_compute(lds, mwA);
    if (kt + 1 < nkt) { ALS(rk1, rv1, 1) }
    __syncthreads();
    if (kt + 1 >= nkt) break;
    const u32x2 mwB_ = mwB;
    if (kt + 3 < nkt) { AGL(rk1, rv1, mwB, kt + 3) }
    tile_compute(lds + 16384, mwB_);
    mwA = mwC;
    if (kt + 2 < nkt) { ALS(rk0, rv0, 0) }
    __syncthreads();
  }
#undef AGL
#undef ALS
  const float ltot = lsum + __shfl_xor(lsum, 32);
  const float inv = 1.f / ltot;
  if (wvalid) {
    bf16_t* za = (bf16_t*)(p.ws + W_ZA) + (size_t)qrow * 512 + h * 64;
#pragma unroll
    for (int db = 0; db < 2; ++db)
#pragma unroll
      for (int g4 = 0; g4 < 4; ++g4) {
        const int d = db * 32 + 8 * g4 + 4 * hl;
        const u32x2 z = *(const u32x2*)(za + d);
        const float z0 = __uint_as_float(z.x << 16), z1 = __uint_as_float(z.x & 0xffff0000u), z2 = __uint_as_float(z.y << 16), z3 = __uint_as_float(z.y & 0xffff0000u);
        *(u32x2*)(za + d) = u32x2{pk2(ot[db][4 * g4] * inv * z0, ot[db][4 * g4 + 1] * inv * z1), pk2(ot[db][4 * g4 + 2] * inv * z2, ot[db][4 * g4 + 3] * inv * z3)};
      }
  }
}

DI void mix_tile(const P& p, int layer, int tile, char* lds) {
  const int lane = tidx() & 63, wave = __builtin_amdgcn_readfirstlane(tidx() >> 6);
  const int mt = tile >> 2, g = tile & 3;
  const int row0 = mt * 128;
  f32x4 acc[4][4];
  zero_acc(acc);
  bf16_t* PA = (bf16_t*)(p.ws + W_POOLED);
  gemm_tile(PA + (size_t)row0 * 512 + g * 128, 512, (const bf16_t*)(p.ws + W_WMIX) + (size_t)(layer * 4 + g) * 128 * 128, 128, 128, 128, acc, lds);
  const int wm = wave >> 1, wn = wave & 1, fr = lane & 15, fq = lane >> 4;
  float* stg = (float*)lds;
  stage_acc(acc, stg, wm, wn, fr, fq);
  __syncthreads();
  const int col = g * 128 + wn * 64 + fr * 4;
  const f32x4 sc = *(const f32x4*)(p.pool_scale + layer * 512 + col);
  u32x2 zr[16];
#pragma unroll
  for (int ps = 0; ps < 16; ++ps) zr[ps] = *(const u32x2*)((const bf16_t*)(p.ws + W_ZP) + (size_t)(row0 + ps * 8 + wm * 4 + fq) * 512 + col);
#pragma unroll
  for (int ps = 0; ps < 16; ++ps) {
    const int lr = ps * 8 + wm * 4 + fq;
    const f32x4 v = *(const f32x4*)(stg + lr * EPS + wn * 64 + fr * 4) * sc;
    const u32x2 z = zr[ps];
    *(u32x2*)(PA + (size_t)(row0 + lr) * 512 + col) = u32x2{pk2(v.x * __uint_as_float(z.x << 16), v.y * __uint_as_float(z.x & 0xffff0000u)), pk2(v.z * __uint_as_float(z.y << 16), v.w * __uint_as_float(z.y & 0xffff0000u))};
  }
  __syncthreads();
}

PHASE_FN void phaseC(const P& p, int layer, char* lds) {
  constexpr int NQ = 8 + 256 + MTILES * 4 / 8;
  int* slot = (int*)(lds + RR_OFF + 496);
  const int x0 = blockIdx.x & 7;
  for (int k = 0; k < 8; ++k) {
    const int x = (x0 + k) & 7;
    unsigned* ctr = (unsigned*)(p.ws + W_BAR) + 3520 + 128 + layer * 512 + x * 64;
    for (;;) {
      const int li = next_ticket(ctr, slot);
      if (li >= NQ) break;
      if (li < 8) attn_item(p, true, li, x, 0, lds);
      else if (li < 264) { const int j = (li - 8) & 127, rr_ = j & 31; attn_item(p, false, (j >> 5) * 4 + (rr_ & 3), x, ((li - 8) < 128 ? 15 : 7) - (rr_ >> 2), lds); }
      else mix_tile(p, layer, (li - 264) * 8 + x, lds);
    }
  }
}

DI void phaseD_tile(const P& p, int layer, int mt, int nt, char* lds) {
  const int lane = tidx() & 63, wave = __builtin_amdgcn_readfirstlane(tidx() >> 6);
  const int row0 = mt * 128, col0 = nt * 128;
  const int wm = wave >> 1, wn = wave & 1, fr = lane & 15, fq = lane >> 4;
  f32x4 acc[4][4];
  zero_acc(acc);
  const size_t goff = ((size_t)((mt * 2 + wm) * 16 + nt * 2 + wn) * 64 + lane) * 16;
  const unsigned* GP = (const unsigned*)(p.ws + W_GP) + goff;
  const unsigned* GA = (const unsigned*)(p.ws + W_GA) + goff;
  u32x4 gpv[4], gav[4];
#pragma unroll
  for (int mi = 0; mi < 4; ++mi) { gpv[mi] = *(const u32x4*)(GP + mi * 4); gav[mi] = *(const u32x4*)(GA + mi * 4); }
  gemm_tile((const bf16_t*)(p.ws + W_POOLED) + (size_t)row0 * 512, 512, (const bf16_t*)(p.ws + W_WPO) + ((size_t)layer * 1024 + col0) * 512, 512, 128, 512, acc, lds);
  gemm_prefetch0((const bf16_t*)(p.ws + W_ZA) + (size_t)row0 * 512, 512, (const bf16_t*)(p.ws + W_WAO) + ((size_t)layer * 1024 + col0) * 512, 512, 128, lds);
#pragma unroll
  for (int mi = 0; mi < 4; ++mi)
#pragma unroll
    for (int ni = 0; ni < 4; ++ni)
#pragma unroll
      for (int j = 0; j < 4; ++j) acc[mi][ni][j] *= (float)((gpv[mi][ni] >> (8 * j)) & 255u) / fmaxf((float)((gav[mi][ni] >> (8 * j)) & 255u), 1.f);
  gemm_tile((const bf16_t*)(p.ws + W_ZA) + (size_t)row0 * 512, 512, (const bf16_t*)(p.ws + W_WAO) + ((size_t)layer * 1024 + col0) * 512, 512, 128, 512, acc, lds, true);
#pragma unroll
  for (int mi = 0; mi < 4; ++mi)
#pragma unroll
    for (int ni = 0; ni < 4; ++ni)
#pragma unroll
      for (int j = 0; j < 4; ++j) acc[mi][ni][j] *= fmaxf((float)((gav[mi][ni] >> (8 * j)) & 255u), 1.f) * (1.f / 255.f);
  float* tile = (float*)lds;
  stage_acc(acc, tile, wm, wn, fr, fq);
  __syncthreads();
  bf16_t* MG = (bf16_t*)(p.ws + W_MERGED);
#pragma unroll 1
  for (int ps = 0; ps < 16; ++ps) {
    const int lr = ps * 8 + wm * 4 + fq;
    const f32x4 v = *(const f32x4*)(tile + lr * EPS + wn * 64 + fr * 4);
    *(u32x2*)(MG + (size_t)(row0 + lr) * LDX + col0 + wn * 64 + fr * 4) = u32x2{pk2(v.x, v.y), pk2(v.z, v.w)};
  }
  __syncthreads();
}

PHASE_FN void phaseD(const P& p, int layer, char* lds) {
  { XcdWalk w; w.init(MTILES, 8); int mt, nt; while (w.next(mt, nt)) phaseD_tile(p, layer, mt, nt, lds); }
}

DI void phaseE_tile(const P& p, int layer, int mt, int nt, char* lds) {
  const int lane = tidx() & 63, wave = __builtin_amdgcn_readfirstlane(tidx() >> 6);
  const int row0 = mt * 128, col0 = nt * 128;
  const int wm = wave >> 1, wn = wave & 1, fr = lane & 15, fq = lane >> 4;
  f32x4 acc[4][4];
  zero_acc(acc);
  float* XF = p.out;
  const int col = col0 + wn * 64 + fr * 4;
  f32x4 xr[16];
#pragma unroll
  for (int ps = 0; ps < 16; ++ps) {
    const int row = row0 + ps * 8 + wm * 4 + fq;
    const float* xin = (layer == 0) ? ((row < NTP) ? p.x_p + (size_t)row * DM : p.x_s + (size_t)(row - NTP) * DM) : XF + (size_t)row * DM;
    xr[ps] = __builtin_nontemporal_load((const f32x4*)(xin + col));
  }
  gemm_tile((const bf16_t*)(p.ws + W_MERGED) + (size_t)row0 * LDX, LDX, (const bf16_t*)(p.ws + W_WO) + ((size_t)layer * 1024 + col0) * LDX, LDX, 128, 1024, acc, lds);
  float* tile = (float*)lds;
  stage_acc(acc, tile, wm, wn, fr, fq);
  __syncthreads();
  bf16_t* XB = (bf16_t*)(p.ws + W_XB);
  float* SS = (float*)(p.ws + W_SS);
#pragma unroll
  for (int ps = 0; ps < 16; ++ps) {
    const int lr = ps * 8 + wm * 4 + fq, row = row0 + lr;
    const f32x4 v = xr[ps] + *(const f32x4*)(tile + lr * EPS + wn * 64 + fr * 4);
    *(f32x4*)(XF + (size_t)row * DM + col) = v;
    if (layer == 0) *(u32x2*)(XB + (size_t)row * DM + col) = u32x2{pk2(v.x, v.y), pk2(v.z, v.w)};
    const float ss = row16_sum(v.x * v.x + v.y * v.y + v.z * v.z + v.w * v.w);
    if (fr == 0) SS[(size_t)row * 16 + nt * 2 + wn] = ss;
  }
  __syncthreads();
}

PHASE_FN void phaseF(const P& p) {
  const int lane = tidx() & 63, wave = __builtin_amdgcn_readfirstlane(tidx() >> 6);
  f32x4 g[4];
#pragma unroll
  for (int j = 0; j < 4; ++j) g[j] = *(const f32x4*)(p.final_g + j * 256 + lane * 4);
  for (int it = blockIdx.x; it < NTOK / 16; it += gridDim.x) {
    const int rowb = it * 16 + wave * 4;
    f32x4 sv[4][4], xv[4][4];
#pragma unroll
    for (int q = 0; q < 4; ++q) {
      const float* sp = (const float*)(p.ws + W_SS) + (size_t)(rowb + q) * 16;
      const float* x = p.out + (size_t)(rowb + q) * DM;
#pragma unroll
      for (int j = 0; j < 4; ++j) { sv[q][j] = *(const f32x4*)(sp + 4 * j); xv[q][j] = *(const f32x4*)(x + j * 256 + lane * 4); }
    }
#pragma unroll
    for (int q = 0; q < 4; ++q) {
      float ss = 0.f;
#pragma unroll
      for (int j = 0; j < 4; ++j) ss += (sv[q][j].x + sv[q][j].y) + (sv[q][j].z + sv[q][j].w);
      const float r = rsqrtf(ss * (1.f / 1024.f) + 1e-6f);
      float* x = p.out + (size_t)(rowb + q) * DM;
#pragma unroll
      for (int j = 0; j < 4; ++j) {
        f32x4 v = xv[q][j];
        v.x *= r * g[j].x; v.y *= r * g[j].y; v.z *= r * g[j].z; v.w *= r * g[j].w;
        __builtin_nontemporal_store(v, (f32x4*)(x + j * 256 + lane * 4));
      }
    }
  }
}

PHASE_FN void phaseA(const P& p, int layer, char* lds) {
  constexpr int MOVE = 21;
  XcdWalk w; w.init(MTILES, NTN);
  const bool split = w.x >= 0 && (MTILES & 7) == 4;
  if (split && w.x < 4) w.total -= MOVE;
  int mt, nt;
  while (w.next(mt, nt)) phaseA_tile(p, layer, mt, nt, lds);
  if (split && w.x >= 4) {
    XcdWalk w2; w2.init(MTILES, NTN);
    w2.x = w.x - 4; w2.mx = (MTILES - w2.x + 7) >> 3; w2.total = w2.mx * NTN; w2.L = w2.total - MOVE + (blockIdx.x >> 3);
    while (w2.next(mt, nt)) phaseA_tile(p, layer, mt, nt, lds);
  }
}
PHASE_FN void phaseE(const P& p, int layer, char* lds) { XcdWalk w; w.init(MTILES, 8); int mt, nt; while (w.next(mt, nt)) phaseE_tile(p, layer, mt, nt, lds); }

DI void run_phase(const P& p, int ph, char* lds) {
  if (ph == 0) { phase0(p, lds); return; }
  if (ph == 11) { phaseF(p); return; }
  const int layer = (ph - 1) / 5, sub = (ph - 1) % 5;
#ifndef SKIP_A
  if (sub == 0) phaseA(p, layer, lds);
#endif
#ifndef SKIP_B
  if (sub == 1) phaseB(p, layer, lds);
#endif
#ifndef SKIP_C
  if (sub == 2) phaseC(p, layer, lds);
#endif
#ifndef SKIP_D
  if (sub == 3) phaseD(p, layer, lds);
#endif
#ifndef SKIP_E
  if (sub == 4) phaseE(p, layer, lds);
#endif
}


#define XB_TMO      128
#define XB_XCNT(j)  (256  + 64 * (j))
#define XB_XSUB(j)  (1280 + 64 * (j))
#define XB_XGEN(j)  (2304 + 64 * (j))
#define XB_TOP      3328
#define XB_TOPGEN   3392
#define XCD_BAR_WORDS 3456
#define XB_SPIN_CAP (1u << 22)
#define LAS __attribute__((address_space(3)))
DI unsigned xb_ld(unsigned* p) { return __hip_atomic_load(p, __ATOMIC_RELAXED, __HIP_MEMORY_SCOPE_AGENT); }
DI unsigned xb_add(unsigned* p, unsigned v) { return __hip_atomic_fetch_add(p, v, __ATOMIC_RELAXED, __HIP_MEMORY_SCOPE_AGENT); }
DI unsigned xb_xcc_id() { return (unsigned)__builtin_amdgcn_s_getreg((3 << 11) | 20) & 0xFu; }
#define XB_SPIN(cond, bar) do { unsigned _sp = 0; while (cond) { __builtin_amdgcn_s_sleep(1); \
    if ((++_sp & 255u) == 0u) { if (xb_ld(&(bar)[XB_TMO])) break; if (_sp > XB_SPIN_CAP) { atomicAdd(&(bar)[XB_TMO], 1u); break; } } } } while (0)
struct XcdBarrier { unsigned* bar; unsigned x; volatile LAS unsigned* st; };
DI XcdBarrier xcd_barrier_post(unsigned* bar, volatile LAS unsigned* st) {
  XcdBarrier b; b.bar = bar; b.x = xb_xcc_id(); b.st = st;
  if (__builtin_amdgcn_workitem_id_x() == 0) (void)xb_add(&bar[XB_XCNT(b.x)], 1u);
  return b;
}
DI void xcd_barrier_complete(unsigned* bar, unsigned x, unsigned& nloc, unsigned& nx) {
  const unsigned G = gridDim.x;
  unsigned sum, cnt, mine, sp = 0u;
  for (;;) {
    sum = 0u; cnt = 0u; mine = 0u;
#pragma unroll
    for (unsigned j = 0; j < 16; ++j) { const unsigned c = xb_ld(&bar[XB_XCNT(j)]); sum += c; cnt += (c > 0u) ? 1u : 0u; mine = (j == x) ? c : mine; }
    if (sum == G) break;
    __builtin_amdgcn_s_sleep(1);
    if ((++sp & 255u) == 0u) { if (xb_ld(&bar[XB_TMO])) break; if (sp > XB_SPIN_CAP) { atomicAdd(&bar[XB_TMO], 1u); break; } }
  }
  nloc = mine > 0u ? mine : 1u; nx = cnt > 0u ? cnt : 1u;
}
DI void xcd_barrier(const XcdBarrier& b) {
  asm volatile("s_waitcnt vmcnt(0)" ::: "memory");
  __syncthreads();
  if (__builtin_amdgcn_workitem_id_x() == 0) {
    unsigned* bar = b.bar;
    __builtin_amdgcn_s_waitcnt(0);
    unsigned nloc = b.st[0], nx = b.st[1];
    if (nloc == 0u) { xcd_barrier_complete(bar, b.x, nloc, nx); b.st[0] = nloc; b.st[1] = nx; }
    const unsigned old = xb_add(&bar[XB_XSUB(b.x)], 1u);
    const unsigned gen = old / nloc;
    if (old + 1u == (gen + 1u) * nloc) {
      __builtin_amdgcn_fence(__ATOMIC_RELEASE, "agent");
      asm volatile("s_waitcnt vmcnt(0)" ::: "memory");
      const unsigned og = xb_add(&bar[XB_TOP], 1u);
      const unsigned tg = og / nx;
      if (og + 1u == (tg + 1u) * nx) xb_add(&bar[XB_TOPGEN], 1u);
      else XB_SPIN(xb_ld(&bar[XB_TOPGEN]) == tg, bar);
      __builtin_amdgcn_fence(__ATOMIC_ACQUIRE, "agent");
      xb_add(&bar[XB_XGEN(b.x)], 1u);
      asm volatile("s_waitcnt vmcnt(0)" ::: "memory");
    } else {
      XB_SPIN(xb_ld(&bar[XB_XGEN(b.x)]) == gen, bar);
      __builtin_amdgcn_fence(__ATOMIC_ACQUIRE, "agent");
      asm volatile("s_waitcnt vmcnt(0)" ::: "memory");
    }
  }
  __syncthreads();
}

__global__ void __launch_bounds__(256, 2) mega(P p, int ph_lo, int ph_hi, int coop) {
  __shared__ __attribute__((aligned(16))) char lds[LDS_BYTES];
  __shared__ uint4 xb_words;
  XcdBarrier xb;
  if (coop) {
    if (__builtin_amdgcn_workitem_id_x() == 0) xb_words = make_uint4(0u, 0u, 0u, 0u);
    __syncthreads();
    xb = xcd_barrier_post((unsigned*)(p.ws + W_BAR), (volatile LAS unsigned*)&xb_words);
  }
  for (int ph = ph_lo; ph < ph_hi; ++ph) {
    run_phase(p, ph, lds);
    if (coop && ph + 1 < ph_hi) {
      if (coop == 2) cg::this_grid().sync();
      xcd_barrier(xb);
    }
  }
}

extern "C" void kernel_launch(void* const* d_in, const int* in_sizes, int n_in, void* d_out, int out_size, void* d_ws, size_t ws_size, hipStream_t stream) {
  if (n_in != 14 || (size_t)out_size != O_END || ws_size < W_END) { fprintf(stderr, "kernel_launch: unexpected shapes (n_in %d out %d ws %zu need %zu)\n", n_in, out_size, ws_size, (size_t)W_END); return; }
  P p{};
  p.x_p = (const float*)d_in[0]; p.x_s = (const float*)d_in[1]; p.cache_k = (const float*)d_in[2]; p.cache_v = (const float*)d_in[3];
  p.cache_ki = (const float*)d_in[4]; p.state_pool = (const float*)d_in[5]; p.norm_g = (const float*)d_in[6]; p.w_in = (const float*)d_in[7];
  p.w_mix = (const float*)d_in[8]; p.pool_scale = (const float*)d_in[9]; p.w_po = (const float*)d_in[10]; p.w_ao = (const float*)d_in[11];
  p.w_o = (const float*)d_in[12]; p.final_g = (const float*)d_in[13];
  p.out = (float*)d_out; p.ws = (char*)d_ws;
  static int grid = 0;
  if (!grid) {
    int dev = 0, cus = 0, per_cu = 0;
    hipGetDevice(&dev);
    hipDeviceGetAttribute(&cus, hipDeviceAttributeMultiprocessorCount, dev);
    hipOccupancyMaxActiveBlocksPerMultiprocessor(&per_cu, mega, 256, 0);
    if (per_cu > 2) per_cu = 2;
    if (per_cu < 1) per_cu = 1;
    grid = cus * per_cu;
  }
#if MULTI_LAUNCH
#ifdef PROBE_SEQ
  const int seq[] = {PROBE_SEQ};
  for (int ph : seq) hipLaunchKernelGGL(mega, dim3(grid), dim3(256), 0, stream, p, ph, ph + 1, 0);
#else
  for (int ph = 0; ph < 12; ++ph) hipLaunchKernelGGL(mega, dim3(grid), dim3(256), 0, stream, p, ph, ph + 1, 0);
#endif
#else
  int lo = 0, hi = 12, coop = 1;
  (void)hipMemsetAsync((char*)d_ws + W_BAR, 0, 32768, stream);
  void* args[] = {&p, &lo, &hi, &coop};
  hipError_t e = hipLaunchCooperativeKernel((void*)mega, dim3(grid), dim3(256), args, 0, stream);
  if (e != hipSuccess) fprintf(stderr, "cooperative launch failed: %s (grid %d)\n", hipGetErrorString(e), grid);
#endif
}
```
